# Optimizing an MI355X kernel written in HIP

```python
import jax, jax.numpy as jnp
from jax import lax
import numpy as np

D_MODEL = 1024
BATCH = 2
SEQ = 16384
DEPTH = 1
DEC_BATCH = 16
DEC_SEQ = 16
PAST_LEN = 2048

CHUNK = 64
N_PREV_CHUNKS = 8
ATT_PAST = N_PREV_CHUNKS * CHUNK
BAND = ATT_PAST + CHUNK
D_MIX = D_MODEL
D_ATT = D_MIX // 2
ATT_HEADS = 8
ATT_HEAD_DIM = D_ATT // ATT_HEADS
D_CONV = D_MIX - D_ATT
CONV_WIDTH = 31
REL_CLIP = 128
N_MEM = 256
MEM_HEADS = 4
MEM_HEAD_DIM = D_MODEL // MEM_HEADS
D_FF = -(-8 * D_MODEL // (3 * 256)) * 256
D_IN = 3 * D_ATT + 2 * D_CONV
EPS = 1e-6
NEG_INF = -1e30

kernel_name = "hybrid_streaming_encoder_step"


def rmsnorm(x, g):
    xf = x.astype(jnp.float32)
    y = xf * lax.rsqrt(jnp.mean(xf * xf, axis=-1, keepdims=True) + EPS)
    return (y * g.astype(jnp.float32)).astype(x.dtype)


def layernorm(x, g, b):
    xf = x.astype(jnp.float32)
    mu = jnp.mean(xf, axis=-1, keepdims=True)
    xc = xf - mu
    var = jnp.mean(xc * xc, axis=-1, keepdims=True)
    y = xc * lax.rsqrt(var + EPS) * g.astype(jnp.float32) + b.astype(jnp.float32)
    return y.astype(x.dtype)


def band_attention(q, k_ext, v_ext, key_valid, rel_bias):
    n_chunks = q.shape[1] // CHUNK
    qi = jnp.arange(CHUNK)[:, None]
    kj = jnp.arange(BAND)[None, :]
    dist = jnp.clip(qi + ATT_PAST - kj, -REL_CLIP, REL_CLIP) + REL_CLIP
    bias = rel_bias[:, dist].astype(jnp.float32)
    scale = ATT_HEAD_DIM ** -0.5

    def one_chunk(c):
        start = c * CHUNK
        qc = lax.dynamic_slice_in_dim(q, start, CHUNK, axis=1)
        kc = lax.dynamic_slice_in_dim(k_ext, start, BAND, axis=1)
        vc = lax.dynamic_slice_in_dim(v_ext, start, BAND, axis=1)
        valid = lax.dynamic_slice_in_dim(key_valid, start, BAND)
        s = jnp.einsum("bqhd,bkhd->bhqk", qc, kc, preferred_element_type=jnp.float32) * scale + bias
        s = jnp.where(valid[None, None, None, :], s, NEG_INF)
        p = jax.nn.softmax(s, axis=-1)
        return jnp.einsum("bhqk,bkhd->bqhd", p.astype(vc.dtype), vc)

    out = lax.map(one_chunk, jnp.arange(n_chunks))
    return jnp.moveaxis(out, 0, 1).reshape(q.shape)


def parallel_mixer(h, past_k, past_v, n_past_valid, keep, conv_buf,
                   w_in, rel_bias, conv_w, conv_b, cln_g, cln_b, w_out):
    B, T, _ = h.shape
    proj = h @ w_in
    q, k, v, u_val, u_gate = jnp.split(
        proj, [D_ATT, 2 * D_ATT, 3 * D_ATT, 3 * D_ATT + D_CONV], axis=-1)
    q = q.reshape(B, T, ATT_HEADS, ATT_HEAD_DIM)
    k = k.reshape(B, T, ATT_HEADS, ATT_HEAD_DIM)
    v = v.reshape(B, T, ATT_HEADS, ATT_HEAD_DIM)

    t_pad = (-T) % CHUNK
    pad = lambda a: jnp.pad(a, ((0, 0), (0, t_pad), (0, 0), (0, 0)))
    k_ext = jnp.concatenate([past_k, pad(k)], axis=1)
    v_ext = jnp.concatenate([past_v, pad(v)], axis=1)
    key_valid = jnp.concatenate([jnp.arange(ATT_PAST) >= ATT_PAST - n_past_valid,
                                 jnp.arange(T + t_pad) < T])
    att = band_attention(pad(q), k_ext, v_ext, key_valid, rel_bias)[:, :T]
    att = att.reshape(B, T, D_ATT)
    end = ATT_PAST + T
    new_k = k_ext[:, end - keep:end]
    new_v = v_ext[:, end - keep:end]

    u = u_val * jax.nn.sigmoid(u_gate)
    u_ext = jnp.concatenate([conv_buf, u], axis=1)
    c = lax.conv_general_dilated(
        u_ext, conv_w[:, None, :], window_strides=(1,), padding="VALID",
        dimension_numbers=("NWC", "WIO", "NWC"), feature_group_count=D_CONV) + conv_b
    c = jax.nn.silu(layernorm(c, cln_g, cln_b))
    new_conv = u_ext[:, -(CONV_WIDTH - 1):]

    y = jnp.concatenate([att, c], axis=-1) @ w_out
    return y, new_k, new_v, new_conv


def memory_kv(mem, g_mem, w_mk, w_mv):
    B = mem.shape[0]
    m = rmsnorm(mem, g_mem)
    mk = (m @ w_mk).reshape(B, N_MEM, MEM_HEADS, MEM_HEAD_DIM)
    mv = (m @ w_mv).reshape(B, N_MEM, MEM_HEADS, MEM_HEAD_DIM)
    return mk, mv


def memory_attention(h, mk, mv, w_mq, w_mo):
    B, T, _ = h.shape
    q = (h @ w_mq).reshape(B, T, MEM_HEADS, MEM_HEAD_DIM)
    s = jnp.einsum("bthd,bmhd->bhtm", q, mk, preferred_element_type=jnp.float32) * (MEM_HEAD_DIM ** -0.5)
    p = jax.nn.softmax(s, axis=-1)
    o = jnp.einsum("bhtm,bmhd->bthd", p.astype(mv.dtype), mv).reshape(B, T, D_MODEL)
    return o @ w_mo


def encoder_layer(x, past_k, past_v, n_past_valid, keep, conv_buf, mk, mv,
                  g_mix_pre, g_mix_post, w_in, rel_bias, conv_w, conv_b, cln_g, cln_b, w_out,
                  g_mem_pre, g_mem_post, w_mq, w_mo,
                  g_ffn_pre, g_ffn_post, w_gate, w_up, w_down):
    h = rmsnorm(x, g_mix_pre)
    y, new_k, new_v, new_conv = parallel_mixer(h, past_k, past_v, n_past_valid, keep, conv_buf,
                                               w_in, rel_bias, conv_w, conv_b, cln_g, cln_b, w_out)
    x = x + rmsnorm(y, g_mix_post)
    h = rmsnorm(x, g_mem_pre)
    x = x + rmsnorm(memory_attention(h, mk, mv, w_mq, w_mo), g_mem_post)
    h = rmsnorm(x, g_ffn_pre)
    f = (jax.nn.silu(h @ w_gate) * (h @ w_up)) @ w_down
    x = x + rmsnorm(f, g_ffn_post)
    return x, new_k, new_v, new_conv


def setup_inputs(seed: int = 0) -> dict:
    key = jax.random.key(seed)
    ks = iter(jax.random.split(key, 40))
    f32 = jnp.float32
    nrm = lambda shape, s: jax.random.normal(next(ks), shape, f32) * s
    gain = lambda shape: 1.0 + nrm(shape, 0.02)
    R = min(ATT_PAST, PAST_LEN)
    return {
        "x_prompt": nrm((BATCH, SEQ, D_MODEL), 1.0),
        "x_sample": nrm((DEC_BATCH, DEC_SEQ, D_MODEL), 1.0),
        "cache_att_k": nrm((DEPTH, DEC_BATCH, R, ATT_HEADS, ATT_HEAD_DIM), 1.0),
        "cache_att_v": nrm((DEPTH, DEC_BATCH, R, ATT_HEADS, ATT_HEAD_DIM), 1.0),
        "cache_conv": nrm((DEPTH, DEC_BATCH, CONV_WIDTH - 1, D_CONV), 0.5),
        "cache_mem_k": nrm((DEPTH, DEC_BATCH, N_MEM, MEM_HEADS, MEM_HEAD_DIM), 1.0),
        "cache_mem_v": nrm((DEPTH, DEC_BATCH, N_MEM, MEM_HEADS, MEM_HEAD_DIM), 1.0),
        "mem_prompt": nrm((BATCH, N_MEM, D_MODEL), 1.0),
        "g_mix_pre": gain((DEPTH, D_MODEL)),
        "g_mix_post": gain((DEPTH, D_MODEL)),
        "w_in": nrm((DEPTH, D_MODEL, D_IN), D_MODEL ** -0.5),
        "rel_bias": nrm((DEPTH, ATT_HEADS, 2 * REL_CLIP + 1), 0.1),
        "conv_w": nrm((DEPTH, CONV_WIDTH, D_CONV), CONV_WIDTH ** -0.5),
        "conv_b": nrm((DEPTH, D_CONV), 0.01),
        "cln_g": gain((DEPTH, D_CONV)),
        "cln_b": nrm((DEPTH, D_CONV), 0.01),
        "w_out": nrm((DEPTH, D_MIX, D_MODEL), D_MIX ** -0.5),
        "g_mem_pre": gain((DEPTH, D_MODEL)),
        "g_mem_post": gain((DEPTH, D_MODEL)),
        "g_mem_kv": gain((DEPTH, D_MODEL)),
        "w_mq": nrm((DEPTH, D_MODEL, D_MODEL), D_MODEL ** -0.5),
        "w_mk": nrm((DEPTH, D_MODEL, D_MODEL), D_MODEL ** -0.5),
        "w_mv": nrm((DEPTH, D_MODEL, D_MODEL), D_MODEL ** -0.5),
        "w_mo": nrm((DEPTH, D_MODEL, D_MODEL), D_MODEL ** -0.5),
        "g_ffn_pre": gain((DEPTH, D_MODEL)),
        "g_ffn_post": gain((DEPTH, D_MODEL)),
        "w_gate": nrm((DEPTH, D_MODEL, D_FF), D_MODEL ** -0.5),
        "w_up": nrm((DEPTH, D_MODEL, D_FF), D_MODEL ** -0.5),
        "w_down": nrm((DEPTH, D_FF, D_MODEL), D_FF ** -0.5),
    }


def reference(x_prompt, x_sample, cache_att_k, cache_att_v, cache_conv, cache_mem_k, cache_mem_v,
              mem_prompt, g_mix_pre, g_mix_post, w_in, rel_bias, conv_w, conv_b, cln_g, cln_b, w_out,
              g_mem_pre, g_mem_post, g_mem_kv, w_mq, w_mk, w_mv, w_mo,
              g_ffn_pre, g_ffn_post, w_gate, w_up, w_down):
    B, T_p, _ = x_prompt.shape
    Bs, T_s, _ = x_sample.shape
    R = cache_att_k.shape[2]
    keep_prompt = min(ATT_PAST, T_p)
    xp, xs = x_prompt, x_sample
    akp, avp, cvp, mkp, mvp, aks, avs, cvs = [], [], [], [], [], [], [], []
    for l in range(DEPTH):
        w = (g_mix_pre[l], g_mix_post[l], w_in[l], rel_bias[l], conv_w[l], conv_b[l], cln_g[l], cln_b[l],
             w_out[l], g_mem_pre[l], g_mem_post[l], w_mq[l], w_mo[l],
             g_ffn_pre[l], g_ffn_post[l], w_gate[l], w_up[l], w_down[l])
        zeros_kv = jnp.zeros((B, ATT_PAST, ATT_HEADS, ATT_HEAD_DIM), xp.dtype)
        zeros_conv = jnp.zeros((B, CONV_WIDTH - 1, D_CONV), xp.dtype)
        mk_p, mv_p = memory_kv(mem_prompt, g_mem_kv[l], w_mk[l], w_mv[l])
        xp, nk_p, nv_p, nc_p = encoder_layer(xp, zeros_kv, zeros_kv, 0, keep_prompt, zeros_conv,
                                             mk_p, mv_p, *w)
        past_pad = ((0, 0), (ATT_PAST - R, 0), (0, 0), (0, 0))
        pk = jnp.pad(cache_att_k[l], past_pad)
        pv = jnp.pad(cache_att_v[l], past_pad)
        xs, nk_s, nv_s, nc_s = encoder_layer(xs, pk, pv, R, R, cache_conv[l],
                                             cache_mem_k[l], cache_mem_v[l], *w)
        akp.append(nk_p); avp.append(nv_p); cvp.append(nc_p); mkp.append(mk_p); mvp.append(mv_p)
        aks.append(nk_s); avs.append(nv_s); cvs.append(nc_s)
    new_att_k_prompt = jnp.stack(akp, 0)
    new_att_v_prompt = jnp.stack(avp, 0)
    new_conv_prompt = jnp.stack(cvp, 0)
    new_mem_k_prompt = jnp.stack(mkp, 0)
    new_mem_v_prompt = jnp.stack(mvp, 0)
    new_att_k_sample = jnp.stack(aks, 0)
    new_att_v_sample = jnp.stack(avs, 0)
    new_conv_sample = jnp.stack(cvs, 0)
    return (xp, xs, new_att_k_prompt, new_att_v_prompt, new_conv_prompt, new_mem_k_prompt,
            new_mem_v_prompt, new_att_k_sample, new_att_v_sample, new_conv_sample)
```

```cpp
#include <hip/hip_runtime.h>
#include <hip/hip_cooperative_groups.h>
#include <cstdio>
namespace cg = cooperative_groups;

#ifndef DUP_MASK
#define DUP_MASK 0
#endif
#ifndef DUP_BAR
#define DUP_BAR 0
#endif
#ifndef N_LAUNCH_PER_PHASE
#define N_LAUNCH_PER_PHASE 0
#endif

#define DI __device__ __forceinline__
#define LAS __attribute__((address_space(3)))
typedef unsigned short bf16_t;
typedef short bf16x8 __attribute__((ext_vector_type(8)));
typedef float f32x4 __attribute__((ext_vector_type(4)));
typedef float f32x16 __attribute__((ext_vector_type(16)));
typedef float f32x2 __attribute__((ext_vector_type(2)));
typedef unsigned u32x4 __attribute__((ext_vector_type(4)));
typedef unsigned u32x2 __attribute__((ext_vector_type(2)));
typedef __bf16 bf2_t __attribute__((ext_vector_type(2)));

constexpr int DM = 1024, TP = 16384, MP = 32768, MS = 256;
constexpr float LOG2E = 1.4426950408889634f;
constexpr float EPS = 1e-6f;
constexpr size_t O_YP = 0, O_YS = O_YP + (size_t)MP * DM, O_AKP = O_YS + 262144, O_AVP = O_AKP + 524288, O_CVP = O_AVP + 524288,
                 O_MKP = O_CVP + 30720, O_MVP = O_MKP + 524288, O_AKS = O_MVP + 524288, O_AVS = O_AKS + 4194304, O_CVS = O_AVS + 4194304;
constexpr size_t W_CTL = 0, W_XBAR = 8192, W_SS = 24576, W_ZERO_END = W_SS + 3 * 32768 * 4;
constexpr size_t W_BT_IN = W_ZERO_END, W_BT_OUT = W_BT_IN + 2560 * 1024 * 2, W_BT_MQ = W_BT_OUT + 2097152, W_BT_MK = W_BT_MQ + 2097152,
                 W_BT_MV = W_BT_MK + 2097152, W_BT_MO = W_BT_MV + 2097152, W_BT_GU = W_BT_MO + 2097152, W_BT_DN = W_BT_GU + 5632 * 1024 * 2,
                 W_H = W_BT_DN + 1024 * 2816 * 2, W_MEMN = W_H + (size_t)33024 * 1024 * 2, W_MK = W_MEMN + 1048576, W_MVT = W_MK + 1048576,
                 W_Y = W_MVT + 1048576, W_Q = W_Y + 67108864, W_K = W_Q + 33554432, W_VT = W_K + 33554432, W_U = W_VT + 33554432,
                 W_MIX = W_U + 33554432, W_SPROJ = W_MIX + 67108864, W_SMIX = W_SPROJ + 256 * 2560 * 4, W_SY = W_SMIX + 524288,
                 W_SX = W_SY + 1048576, W_SQM = W_SX + 1048576, W_SOM = W_SQM + 1048576, W_SHID = W_SOM + 524288, W_XR = W_SHID + 256 * 2816 * 2, W_XRS2 = W_XR + (size_t)33024 * 1024 * 2, W_XCH = W_XRS2 + 256 * 1024 * 2, W_END = W_XCH + (size_t)3 * 2 * 32768 * 4 * 4;
constexpr size_t W_QM = W_Q, W_P = W_VT, W_OM = W_MIX, W_HID = W_Q;
constexpr int L_STAGE = 0, L_X = 131072, L_BIAS = L_X + 8192, L_MISC = L_BIAS + 8448, LDS_BYTES = L_MISC + 4096;

struct Params { const float* in[29]; float* out; unsigned char* ws; int ph_lo, ph_hi; };

DI unsigned pk_bf16(float lo, float hi) { f32x2 v = {lo, hi}; bf2_t b = __builtin_convertvector(v, bf2_t); return __builtin_bit_cast(unsigned, b); }
DI float bf_lo(unsigned w) { return __uint_as_float(w << 16); }
DI float bf_hi(unsigned w) { return __uint_as_float(w & 0xffff0000u); }
DI float fast_exp2(float x) { return __builtin_amdgcn_exp2f(x); }
DI float sigmoidf_(float x) { return __builtin_amdgcn_rcpf(1.0f + fast_exp2(-x * LOG2E)); }
DI int perm16(int k) { return 8 * ((k >> 2) & 1) + 4 * (k >> 3) + (k & 3); }
DI int crow(int i, int h) { return (i & 3) + 8 * (i >> 2) + 4 * h; }
DI int ltid(int wv) { int l; asm volatile("v_mbcnt_lo_u32_b32 %0, -1, 0\n\tv_mbcnt_hi_u32_b32 %0, -1, %0" : "=v"(l)); return wv * 64 + l; }
DI int lzero() { int z = 0; asm volatile("" : "+s"(z)); return z; }
DI float xh_max(float v) { const unsigned u = __float_as_uint(v); const auto r = __builtin_amdgcn_permlane32_swap(u, u, false, false); return fmaxf(__uint_as_float(r[0]), __uint_as_float(r[1])); }
DI float xh_sum(float v) { const unsigned u = __float_as_uint(v); const auto r = __builtin_amdgcn_permlane32_swap(u, u, false, false); return __uint_as_float(r[0]) + __uint_as_float(r[1]); }
DI float xr_max(float v) { const unsigned u = __float_as_uint(v); const auto r = __builtin_amdgcn_permlane16_swap(u, u, false, false); return fmaxf(__uint_as_float(r[0]), __uint_as_float(r[1])); }
DI float xr_sum(float v) { const unsigned u = __float_as_uint(v); const auto r = __builtin_amdgcn_permlane16_swap(u, u, false, false); return __uint_as_float(r[0]) + __uint_as_float(r[1]); }
#define MFMA32(a, b, c) __builtin_amdgcn_mfma_f32_32x32x16_bf16((a), (b), (c), 0, 0, 0)

constexpr int BM = 256, BK = 64, HALF = 128, HTB = HALF * BK * 2, NXCD = 8, WGM = 8;
DI int lds_byte(int r, int c) { const int st = (r >> 4) * 2 + (c >> 5), rr = r & 15, cc = c & 31, ob = rr * 64 + cc * 2; return st * 1024 + (ob ^ (((ob >> 9) & 1) << 5)); }
DI void stage_rc(int b, int& R, int& C) { const int st = b / 1024, sb = b % 1024, swz = sb ^ (((sb >> 9) & 1) << 5); R = (st >> 1) * 16 + swz / 64; C = (st & 1) * 32 + (swz % 64) / 2; }
DI int perm32(int rho) { const int n = rho >> 4, i = rho & 15; return 8 * (i >> 2) + 4 * n + (i & 3); }

struct Unit { int pm, pn, kind; };
struct GemmDesc { const bf16_t* A; const bf16_t* Bt; const bf16_t* A2; int lda, ldb, K, nM, nN, mode; };
enum { EPI_G1 = 0, EPI_KV = 1, EPI_Y = 2, EPI_BF = 3, EPI_S = 4, EPI_GU = 5, EPI_YN = 6 };
struct EpiArgs { bf16_t* o; int ldo; float scale; float* ss; int stage; };

DI bool sched_next(const GemmDesc& g, int i, int c, int G, Unit& u) {
    if (g.mode == 3) { if (i > 0 || c >= 16) return false; if (c < 8) { u.pm = c >> 2; u.pn = c & 3; u.kind = 0; } else { u.pm = (c - 8) >> 1; u.pn = (c - 8) & 1; u.kind = 1; } return true; }
    const int nwg = g.nM * g.nN; const long L = (long)i * G + c; if (L >= nwg) return false;
    int wgid = (int)L; { const int q = nwg / NXCD, r = nwg % NXCD, xcd = wgid % NXCD, off = wgid / NXCD; wgid = (xcd < r ? xcd * (q + 1) : r * (q + 1) + (xcd - r) * q) + off; }
    const int nig = WGM * g.nN, gid = wgid / nig, fm = gid * WGM, gsz = (g.nM - fm) < WGM ? (g.nM - fm) : WGM;
    u.pm = fm + ((wgid % nig) % gsz); u.pn = (wgid % nig) / gsz; u.kind = 0; return true;
}
DI void unit_ptrs(const GemmDesc& g, const Unit& u, const char*& cA, const char*& cB) {
    if (g.mode == 0) { cA = (const char*)g.A + (size_t)u.pm * 256 * g.lda * 2; cB = (const char*)g.Bt + (size_t)u.pn * 256 * g.ldb * 2; }
    else if (g.mode == 1) { cA = (const char*)g.A + ((size_t)u.pm * 256 * g.lda + u.pn * 256) * 2; cB = (const char*)g.Bt + ((size_t)(u.pm >> 6) * 256 * g.ldb + u.pn * 256) * 2; }
    else if (g.mode == 2) { cA = (const char*)g.A + ((size_t)u.pm * 256 * g.lda + u.pn * 256) * 2; cB = (const char*)g.Bt + ((size_t)u.pn * 256 * g.ldb + (u.pm >> 6) * 256) * 2; }
    else { if (u.kind == 0) { cA = (const char*)g.A + (size_t)u.pm * 256 * 1024 * 2; cB = (const char*)g.Bt + (size_t)u.pn * 256 * 1024 * 2; }
           else { cA = (const char*)g.A2 + (size_t)u.pm * 256 * 1024 * 2; cB = (const char*)g.A + (size_t)u.pn * 256 * 1024 * 2; } }
}

template <int EPI>
DI void epilogue(const Params& p, const EpiArgs& e, f32x4 (&acc)[2][2][4][2], const Unit& u, int wr, int wc, int fr, int fq, LAS unsigned char* lds) {
    unsigned char* ws = p.ws; asm volatile("" : "+v"(fr), "+v"(fq));
    if constexpr (EPI == EPI_G1) {
        const int b = u.pm >> 6, tb = (u.pm & 63) * 256, pn = u.pn;
        const bool tail = (u.pm & 63) >= 62;
#pragma unroll
        for (int ai = 0; ai < 2; ++ai)
#pragma unroll
            for (int m = 0; m < 4; ++m) {
                const int rl = 128 * ai + 64 * wr + 16 * m + fr; const int t = tb + rl; const size_t grow = (size_t)u.pm * 256 + rl;
                if (pn < 2) {
                    const float sc = 0.125f * LOG2E;
#pragma unroll
                    for (int bj = 0; bj < 2; ++bj) { const int col = 256 * pn + 128 * bj + 32 * wc + 8 * fq; const f32x4 v0 = acc[ai][bj][m][0] * sc, v1 = acc[ai][bj][m][1] * sc;
                        u32x4 w; w.x = pk_bf16(v0[0], v0[1]); w.y = pk_bf16(v0[2], v0[3]); w.z = pk_bf16(v1[0], v1[1]); w.w = pk_bf16(v1[2], v1[3]);
                        *(u32x4*)((bf16_t*)(ws + W_Q) + grow * 512 + col) = w; }
                } else if (pn < 4) {
#pragma unroll
                    for (int bj = 0; bj < 2; ++bj) { const int col = 256 * (pn - 2) + 128 * bj + 32 * wc + 8 * fq; const f32x4 v0 = acc[ai][bj][m][0], v1 = acc[ai][bj][m][1];
                        u32x4 w; w.x = pk_bf16(v0[0], v0[1]); w.y = pk_bf16(v0[2], v0[3]); w.z = pk_bf16(v1[0], v1[1]); w.w = pk_bf16(v1[2], v1[3]);
                        *(u32x4*)((bf16_t*)(ws + W_K) + grow * 512 + col) = w;
                        if (tail) { float* o = p.out + O_AKP + ((size_t)b * 512 + (t - 15872)) * 512 + col; *(f32x4*)o = v0; *(f32x4*)(o + 4) = v1; } }
                } else if (pn < 6) {
#pragma unroll
                    for (int bj = 0; bj < 2; ++bj) { const int col = 256 * (pn - 4) + 128 * bj + 32 * wc + 8 * fq; const f32x4 v0 = acc[ai][bj][m][0], v1 = acc[ai][bj][m][1];
                        bf16_t* vt = (bf16_t*)(ws + W_VT) + ((size_t)b * 512 + col) * TP + (t & ~15) + perm16(t & 15);
#pragma unroll
                        for (int j = 0; j < 4; ++j) { vt[(size_t)j * TP] = (bf16_t)(pk_bf16(v0[j], 0.f) & 0xffffu); vt[(size_t)(4 + j) * TP] = (bf16_t)(pk_bf16(v1[j], 0.f) & 0xffffu); }
                        if (tail) { float* o = p.out + O_AVP + ((size_t)b * 512 + (t - 15872)) * 512 + col; *(f32x4*)o = v0; *(f32x4*)(o + 4) = v1; } }
                } else {
                    const int ch = 128 * (pn - 6) + 32 * wc + 8 * fq; f32x4 u0, u1;
#pragma unroll
                    for (int j = 0; j < 4; ++j) { u0[j] = acc[ai][0][m][0][j] * sigmoidf_(acc[ai][1][m][0][j]); u1[j] = acc[ai][0][m][1][j] * sigmoidf_(acc[ai][1][m][1][j]); }
                    u32x4 w; w.x = pk_bf16(u0[0], u0[1]); w.y = pk_bf16(u0[2], u0[3]); w.z = pk_bf16(u1[0], u1[1]); w.w = pk_bf16(u1[2], u1[3]);
                    *(u32x4*)((bf16_t*)(ws + W_U) + grow * 512 + ch) = w;
                    if (t >= TP - 30) { float* o = p.out + O_CVP + ((size_t)b * 30 + (t - (TP - 30))) * 512 + ch; *(f32x4*)o = u0; *(f32x4*)(o + 4) = u1; }
                }
            }
    } else if constexpr (EPI == EPI_KV) {
#pragma unroll
        for (int ai = 0; ai < 2; ++ai)
#pragma unroll
            for (int m = 0; m < 4; ++m)
#pragma unroll
                for (int bj = 0; bj < 2; ++bj) {
                    const int row = 256 * u.pm + 128 * ai + 64 * wr + 16 * m + fr, col = 256 * u.pn + 128 * bj + 32 * wc + 8 * fq;
                    const f32x4 v0 = acc[ai][bj][m][0], v1 = acc[ai][bj][m][1];
                    u32x4 w; w.x = pk_bf16(v0[0], v0[1]); w.y = pk_bf16(v0[2], v0[3]); w.z = pk_bf16(v1[0], v1[1]); w.w = pk_bf16(v1[2], v1[3]);
                    if (u.kind == 0) { *(u32x4*)((bf16_t*)(ws + W_MK) + (size_t)row * 1024 + col) = w; float* o = p.out + O_MKP + (size_t)row * 1024 + col; *(f32x4*)o = v0; *(f32x4*)(o + 4) = v1; }
                    else { *(u32x4*)((bf16_t*)(ws + W_MVT) + (size_t)row * 512 + col) = w; float* o = p.out + O_MVP + (size_t)col * 1024 + row;
#pragma unroll
                        for (int j = 0; j < 4; ++j) { o[(size_t)j * 1024] = v0[j]; o[(size_t)(4 + j) * 1024] = v1[j]; } }
                }
    } else if constexpr (EPI == EPI_Y) {
#pragma unroll
        for (int ai = 0; ai < 2; ++ai)
#pragma unroll
            for (int m = 0; m < 4; ++m) {
                const size_t row = (size_t)256 * u.pm + 128 * ai + 64 * wr + 16 * m + fr; float ss = 0.f;
#pragma unroll
                for (int bj = 0; bj < 2; ++bj) { const int col = 256 * u.pn + 128 * bj + 32 * wc + 8 * fq; const f32x4 v0 = acc[ai][bj][m][0], v1 = acc[ai][bj][m][1];
                    ss += (v0[0] * v0[0] + v0[1] * v0[1]) + (v0[2] * v0[2] + v0[3] * v0[3]) + (v1[0] * v1[0] + v1[1] * v1[1]) + (v1[2] * v1[2] + v1[3] * v1[3]);
                    u32x4 w; w.x = pk_bf16(v0[0], v0[1]); w.y = pk_bf16(v0[2], v0[3]); w.z = pk_bf16(v1[0], v1[1]); w.w = pk_bf16(v1[2], v1[3]);
                    *(u32x4*)(e.o + row * e.ldo + col) = w; }
                ss = xr_sum(ss); ss = xh_sum(ss);
                if (fq == 0) __hip_atomic_fetch_add(e.ss + row, ss, __ATOMIC_RELAXED, __HIP_MEMORY_SCOPE_AGENT);
            }
    } else if constexpr (EPI == EPI_BF) {
#pragma unroll
        for (int ai = 0; ai < 2; ++ai)
#pragma unroll
            for (int m = 0; m < 4; ++m)
#pragma unroll
                for (int bj = 0; bj < 2; ++bj) {
                    const size_t row = (size_t)256 * u.pm + 128 * ai + 64 * wr + 16 * m + fr; const int col = 256 * u.pn + 128 * bj + 32 * wc + 8 * fq;
                    const f32x4 v0 = acc[ai][bj][m][0] * e.scale, v1 = acc[ai][bj][m][1] * e.scale;
                    u32x4 w; w.x = pk_bf16(v0[0], v0[1]); w.y = pk_bf16(v0[2], v0[3]); w.z = pk_bf16(v1[0], v1[1]); w.w = pk_bf16(v1[2], v1[3]);
                    *(u32x4*)(e.o + row * e.ldo + col) = w; }
    } else if constexpr (EPI == EPI_S) {
        LAS f32x2* X = (LAS f32x2*)(lds + L_X);
#pragma unroll
        for (int ai = 0; ai < 2; ++ai)
#pragma unroll
            for (int m = 0; m < 4; ++m) {
                float mx = -3.0e38f;
#pragma unroll
                for (int bj = 0; bj < 2; ++bj)
#pragma unroll
                    for (int n = 0; n < 2; ++n)
#pragma unroll
                        for (int j = 0; j < 4; ++j) mx = fmaxf(mx, acc[ai][bj][m][n][j]);
                mx = xr_max(mx); mx = xh_max(mx);
                float s = 0.f;
#pragma unroll
                for (int bj = 0; bj < 2; ++bj)
#pragma unroll
                    for (int n = 0; n < 2; ++n)
#pragma unroll
                        for (int j = 0; j < 4; ++j) { const float pv = fast_exp2(acc[ai][bj][m][n][j] - mx); acc[ai][bj][m][n][j] = pv; s += pv; }
                s = xr_sum(s); s = xh_sum(s);
                if (fq == 0) X[(128 * ai + 64 * wr + 16 * m + fr) * 4 + wc] = (f32x2){mx, s};
            }
        asm volatile("s_waitcnt lgkmcnt(0)" ::: "memory"); __builtin_amdgcn_s_barrier(); asm volatile("" ::: "memory");
#pragma unroll
        for (int ai = 0; ai < 2; ++ai)
#pragma unroll
            for (int m = 0; m < 4; ++m) {
                const int rl = 128 * ai + 64 * wr + 16 * m + fr;
                const f32x2 x0 = X[rl * 4 + 0], x1 = X[rl * 4 + 1], x2 = X[rl * 4 + 2], x3 = X[rl * 4 + 3];
                const float M = fmaxf(fmaxf(x0.x, x1.x), fmaxf(x2.x, x3.x));
                const float L = x0.y * fast_exp2(x0.x - M) + x1.y * fast_exp2(x1.x - M) + x2.y * fast_exp2(x2.x - M) + x3.y * fast_exp2(x3.x - M);
                const float own = wc == 0 ? x0.x : (wc == 1 ? x1.x : (wc == 2 ? x2.x : x3.x));
                const float f = fast_exp2(own - M) / L; const size_t row = (size_t)256 * u.pm + rl;
#pragma unroll
                for (int bj = 0; bj < 2; ++bj) { const int col = 256 * u.pn + 128 * bj + 32 * wc + 8 * fq; const f32x4 v0 = acc[ai][bj][m][0] * f, v1 = acc[ai][bj][m][1] * f;
                    u32x4 w; w.x = pk_bf16(v0[0], v0[1]); w.y = pk_bf16(v0[2], v0[3]); w.z = pk_bf16(v1[0], v1[1]); w.w = pk_bf16(v1[2], v1[3]);
                    *(u32x4*)(e.o + row * e.ldo + col) = w; }
                asm volatile("" ::: "memory");
            }
    } else if constexpr (EPI == EPI_YN) {
        const int stage = e.stage, pm = u.pm, pn = u.pn;
        LAS float* Xs = (LAS float*)(lds + L_X);
        const float* gpost = p.in[stage == 0 ? 9 : (stage == 1 ? 18 : 25)];
        const float* gpre = p.in[stage == 0 ? 17 : 24];
        bf16_t* XR = (bf16_t*)(ws + W_XR); bf16_t* Hb = (bf16_t*)(ws + W_H);
        const size_t row0 = (size_t)256 * pm + 64 * wr + fr; const int col0 = 256 * pn + 32 * wc + 8 * fq;
        u32x4 xw[4][2];
#pragma unroll
        for (int m = 0; m < 4; ++m)
#pragma unroll
            for (int bj = 0; bj < 2; ++bj) xw[m][bj] = *(const u32x4*)(XR + (row0 + 16 * m) * DM + col0 + 128 * bj);
#pragma unroll
        for (int ex = 0; ex < 2; ++ex) {
            if (ex == 1 && stage == 2) break;
#pragma unroll
            for (int ai = 0; ai < 2; ++ai)
#pragma unroll
                for (int m = 0; m < 4; ++m) { float ss = 0.f;
#pragma unroll
                    for (int bj = 0; bj < 2; ++bj) { const f32x4 v0 = acc[ai][bj][m][0], v1 = acc[ai][bj][m][1];
                        ss += (v0[0] * v0[0] + v0[1] * v0[1]) + (v0[2] * v0[2] + v0[3] * v0[3]) + (v1[0] * v1[0] + v1[1] * v1[1]) + (v1[2] * v1[2] + v1[3] * v1[3]); }
                    ss = xr_sum(ss); ss = xh_sum(ss);
                    if (fq == 0) Xs[ex * 1024 + (128 * ai + 64 * wr + 16 * m + fr) * 4 + wc] = ss; }
            asm volatile("s_waitcnt lgkmcnt(0)" ::: "memory"); __builtin_amdgcn_s_barrier(); asm volatile("" ::: "memory");
            float* xch = (float*)(ws + W_XCH) + ((size_t)(stage * 2 + ex) * 32768 + (size_t)pm * 256) * 4;
            unsigned* cnt = (unsigned*)(ws + W_CTL) + 1024 + ((stage * 2 + ex) * 128 + pm) * 2 + wr;
            if (wc == 0) {
                if (fq == 0) {
#pragma unroll
                    for (int ai = 0; ai < 2; ++ai)
#pragma unroll
                        for (int m = 0; m < 4; ++m) { const int rl = 128 * ai + 64 * wr + 16 * m + fr; const f32x4 t = *(const LAS f32x4*)(Xs + ex * 1024 + rl * 4);
                            __hip_atomic_store(xch + rl * 4 + pn, (t[0] + t[1]) + (t[2] + t[3]), __ATOMIC_RELAXED, __HIP_MEMORY_SCOPE_AGENT); }
                }
                asm volatile("s_waitcnt vmcnt(0)" ::: "memory");
                if (fr == 0 && fq == 0) __hip_atomic_fetch_add(cnt, 1u, __ATOMIC_RELAXED, __HIP_MEMORY_SCOPE_AGENT);
                while ((unsigned)__builtin_amdgcn_readfirstlane((int)__hip_atomic_load(cnt, __ATOMIC_RELAXED, __HIP_MEMORY_SCOPE_AGENT)) < 4u) __builtin_amdgcn_s_sleep(1);
            }
            asm volatile("" ::: "memory"); __builtin_amdgcn_s_barrier(); asm volatile("" ::: "memory");
            float rsv[2][4];
#pragma unroll
            for (int ai = 0; ai < 2; ++ai) { unsigned long long tq[4][2];
#pragma unroll
                for (int m = 0; m < 4; ++m) { const unsigned long long* q = (const unsigned long long*)(xch + (128 * ai + 64 * wr + 16 * m + fr) * 4);
                    tq[m][0] = __hip_atomic_load(q, __ATOMIC_RELAXED, __HIP_MEMORY_SCOPE_AGENT); tq[m][1] = __hip_atomic_load(q + 1, __ATOMIC_RELAXED, __HIP_MEMORY_SCOPE_AGENT); }
#pragma unroll
                for (int m = 0; m < 4; ++m) { const float t0 = __uint_as_float((unsigned)tq[m][0]), t1 = __uint_as_float((unsigned)(tq[m][0] >> 32)), t2 = __uint_as_float((unsigned)tq[m][1]), t3 = __uint_as_float((unsigned)(tq[m][1] >> 32));
                    rsv[ai][m] = rsqrtf(((t0 + t1) + (t2 + t3)) * (1.0f / 1024.0f) + EPS); } }
#pragma unroll
            for (int ai = 0; ai < 2; ++ai) {
            if (ex == 0 && ai == 1) { asm volatile("" ::: "memory");
#pragma unroll
                for (int m = 0; m < 4; ++m)
#pragma unroll
                    for (int bj = 0; bj < 2; ++bj) xw[m][bj] = *(const u32x4*)(XR + (row0 + 128 + 16 * m) * DM + col0 + 128 * bj);
            }
#pragma unroll
            for (int bj = 0; bj < 2; ++bj) { const int col = col0 + 128 * bj;
                const float* gp = ex == 0 ? gpost : gpre; const f32x4 g0 = *(const f32x4*)(gp + col), g1 = *(const f32x4*)(gp + col + 4);
                {
#pragma unroll
                    for (int m = 0; m < 4; ++m) { const size_t row = row0 + 128 * ai + 16 * m; const float rs = rsv[ai][m];
                        if (ex == 0) {
                            const u32x4 w = xw[m][bj];
                            const f32x4 x0 = (f32x4){bf_lo(w.x), bf_hi(w.x), bf_lo(w.y), bf_hi(w.y)}, x1 = (f32x4){bf_lo(w.z), bf_hi(w.z), bf_lo(w.w), bf_hi(w.w)};
                            const f32x4 n0 = x0 + acc[ai][bj][m][0] * rs * g0, n1 = x1 + acc[ai][bj][m][1] * rs * g1;
                            acc[ai][bj][m][0] = n0; acc[ai][bj][m][1] = n1;
                            if (stage == 2) { float* o = p.out + O_YP + row * DM + col; *(f32x4*)o = n0; *(f32x4*)(o + 4) = n1; }
                            else { u32x4 wo; wo.x = pk_bf16(n0[0], n0[1]); wo.y = pk_bf16(n0[2], n0[3]); wo.z = pk_bf16(n1[0], n1[1]); wo.w = pk_bf16(n1[2], n1[3]); *(u32x4*)(XR + row * DM + col) = wo; }
                        } else {
                            const f32x4 h0 = acc[ai][bj][m][0] * rs * g0, h1 = acc[ai][bj][m][1] * rs * g1;
                            u32x4 wo; wo.x = pk_bf16(h0[0], h0[1]); wo.y = pk_bf16(h0[2], h0[3]); wo.z = pk_bf16(h1[0], h1[1]); wo.w = pk_bf16(h1[2], h1[3]); *(u32x4*)(Hb + row * DM + col) = wo;
                        }
                    }
                }
            }
            }
        }
    } else {
#pragma unroll
        for (int ai = 0; ai < 2; ++ai)
#pragma unroll
            for (int m = 0; m < 4; ++m) {
                const size_t row = (size_t)256 * u.pm + 128 * ai + 64 * wr + 16 * m + fr; const int ch = 128 * u.pn + 32 * wc + 8 * fq; f32x4 u0, u1;
#pragma unroll
                for (int j = 0; j < 4; ++j) { const float g0 = acc[ai][0][m][0][j], g1 = acc[ai][0][m][1][j]; u0[j] = g0 * sigmoidf_(g0) * acc[ai][1][m][0][j]; u1[j] = g1 * sigmoidf_(g1) * acc[ai][1][m][1][j]; }
                u32x4 w; w.x = pk_bf16(u0[0], u0[1]); w.y = pk_bf16(u0[2], u0[3]); w.z = pk_bf16(u1[0], u1[1]); w.w = pk_bf16(u1[2], u1[3]);
                *(u32x4*)(e.o + row * e.ldo + ch) = w; }
    }
}

template <int EPI>
DI void gemm_phase(LAS unsigned char* lds, const Params& p, const GemmDesc g, const EpiArgs e, const int c, const int G, const int wv) {
    const int tid = ltid(wv), wid = __builtin_amdgcn_readfirstlane(tid >> 6), lane = tid & 63, wr = wid >> 2, wc = wid & 3, fr = lane & 15, fq = lane >> 4;
    const int K = g.K, nt = K / BK;
    unsigned voffA[2], voffB[2];
#pragma unroll
    for (int i = 0; i < 2; ++i) { int R, C; stage_rc(tid * 16 + i * 8192, R, C); const int Rb = (R & ~31) + perm32(R & 31);
        voffA[i] = (unsigned)(R * g.lda + C) * 2u; voffB[i] = (unsigned)(Rb * g.ldb + C) * 2u; }
    const size_t kstep = (size_t)(BK * 2);
    const size_t hstepA = (size_t)HALF * g.lda * 2, hstepB = (size_t)HALF * g.ldb * 2;
    const unsigned ldsw = (unsigned)wid * 1024u;
    const int aoff = lds_byte(wr * 64 + fr, fq * 8), boff = lds_byte(wc * 32 + fr, fq * 8);
#define G_SA(b, h) (((b) * 2 + (h)) * HTB)
#define G_SB(b, h) ((4 + (b) * 2 + (h)) * HTB)
#define G_STAGE(bufoff, gbase, voff) do { _Pragma("unroll") for (int _i = 0; _i < 2; ++_i) \
        __builtin_amdgcn_global_load_lds((const unsigned*)((const char*)(gbase) + (voff)[_i]), (LAS unsigned*)(lds + (bufoff) + ldsw + _i * 8192), 16, 0, 0); } while (0)
#define G_LDA(dst, b, h) do { _Pragma("unroll") for (int m = 0; m < 4; ++m) _Pragma("unroll") for (int k = 0; k < 2; ++k) dst[m][k] = *(const LAS bf16x8*)(lds + G_SA(b, h) + aoff + m * 2048 + k * 1024); } while (0)
#define G_LDB(dst, b, h) do { _Pragma("unroll") for (int n = 0; n < 2; ++n) _Pragma("unroll") for (int k = 0; k < 2; ++k) dst[n][k] = *(const LAS bf16x8*)(lds + G_SB(b, h) + boff + n * 2048 + k * 1024); } while (0)
#define G_MMA(ai, bj, At, Bt) do { __builtin_amdgcn_s_setprio(1); _Pragma("unroll") for (int m = 0; m < 4; ++m) _Pragma("unroll") for (int n = 0; n < 2; ++n) _Pragma("unroll") for (int k = 0; k < 2; ++k) \
        acc[ai][bj][m][n] = __builtin_amdgcn_mfma_f32_16x16x32_bf16(Bt[n][k], At[m][k], acc[ai][bj][m][n], 0, 0, 0); __builtin_amdgcn_s_setprio(0); } while (0)
#define G_WAIT_V(n) asm volatile("s_waitcnt vmcnt(" #n ")" ::: "memory")
#define G_WAIT_L(n) asm volatile("s_waitcnt lgkmcnt(" #n ")" ::: "memory")
#define G_BAR __builtin_amdgcn_s_barrier()
#define G_SCHED __builtin_amdgcn_sched_barrier(0)
    Unit cur, nxt; int ui = 0;
    if (!sched_next(g, 0, c, G, cur)) return;
    f32x4 acc[2][2][4][2];
#pragma unroll
    for (int a = 0; a < 2; ++a)
#pragma unroll
        for (int b = 0; b < 2; ++b)
#pragma unroll
            for (int m = 0; m < 4; ++m)
#pragma unroll
                for (int n = 0; n < 2; ++n) acc[a][b][m][n] = (f32x4){0.f, 0.f, 0.f, 0.f};
    bf16x8 At[4][2], B0[2][2], B1[2][2];
    const char* cA; const char* cB; unit_ptrs(g, cur, cA, cB);
    G_STAGE(G_SB(0, 0), cB, voffB); G_STAGE(G_SA(0, 0), cA, voffA); G_STAGE(G_SB(0, 1), cB + hstepB, voffB); G_STAGE(G_SA(0, 1), cA + hstepA, voffA);
    if (wr == 1) G_BAR;
    G_WAIT_V(4); G_BAR;
    G_STAGE(G_SB(1, 0), cB + kstep, voffB); G_STAGE(G_SA(1, 0), cA + kstep, voffA); G_STAGE(G_SB(1, 1), cB + hstepB + kstep, voffB);
    G_WAIT_V(6); G_BAR;
    for (;;) {
        const bool has_next = sched_next(g, ui + 1, c, G, nxt);
        const char* nA = cA; const char* nB = cB; if (has_next) unit_ptrs(g, nxt, nA, nB);
        for (int t = 0; t < nt; t += 2) {
            const bool last = (t == nt - 2);
            const char* a1 = cA + (size_t)(t + 1) * kstep;
            const char* a2 = last ? nA : cA + (size_t)(t + 2) * kstep; const char* b2 = last ? nB : cB + (size_t)(t + 2) * kstep;
            const char* a3 = a2 + kstep; const char* b3 = b2 + kstep;
            G_LDB(B0, 0, 0); G_SCHED; G_LDA(At, 0, 0); G_STAGE(G_SA(1, 1), a1 + hstepA, voffA);
            G_WAIT_L(8); G_BAR; G_WAIT_L(0); G_MMA(0, 0, At, B0); G_BAR; G_SCHED;
            G_LDB(B1, 0, 1); G_STAGE(G_SB(0, 0), b2, voffB);
            G_BAR; G_WAIT_L(0); G_MMA(0, 1, At, B1); G_BAR;
            G_LDA(At, 0, 1); G_STAGE(G_SA(0, 0), a2, voffA);
            G_BAR; G_WAIT_L(0); G_MMA(1, 0, At, B0); G_BAR; G_SCHED;
            G_STAGE(G_SB(0, 1), b2 + hstepB, voffB);
            G_WAIT_V(6); G_BAR; G_MMA(1, 1, At, B1); G_BAR;
            G_LDB(B0, 1, 0); G_SCHED; G_LDA(At, 1, 0); G_STAGE(G_SA(0, 1), a2 + hstepA, voffA);
            G_WAIT_L(8); G_BAR; G_WAIT_L(0); G_MMA(0, 0, At, B0); G_BAR; G_SCHED;
            G_LDB(B1, 1, 1); G_STAGE(G_SB(1, 0), b3, voffB);
            G_BAR; G_WAIT_L(0); G_MMA(0, 1, At, B1); G_BAR;
            G_LDA(At, 1, 1); G_STAGE(G_SA(1, 0), a3, voffA);
            G_BAR; G_WAIT_L(0); G_MMA(1, 0, At, B0); G_BAR; G_SCHED;
            G_STAGE(G_SB(1, 1), b3 + hstepB, voffB);
            G_WAIT_V(6); G_BAR; G_MMA(1, 1, At, B1); G_BAR;
        }
        epilogue<EPI>(p, e, acc, cur, wr, wc, fr, fq, lds);
        if (!has_next) break;
#pragma unroll
        for (int a = 0; a < 2; ++a)
#pragma unroll
            for (int b = 0; b < 2; ++b)
#pragma unroll
                for (int m = 0; m < 4; ++m)
#pragma unroll
                    for (int n = 0; n < 2; ++n) acc[a][b][m][n] = (f32x4){0.f, 0.f, 0.f, 0.f};
        cur = nxt; cA = nA; cB = nB; ++ui;
    }
    G_WAIT_V(0);
    if (wr == 0) G_BAR;
    G_BAR;
#undef G_SA
#undef G_SB
#undef G_STAGE
#undef G_LDA
#undef G_LDB
#undef G_MMA
#undef G_WAIT_V
#undef G_WAIT_L
#undef G_BAR
#undef G_SCHED
}

template <int KS, bool PAIR>
DI void small_gemm(LAS unsigned char* lds, const bf16_t* A, int lda, const bf16_t* Bt, int ldb, int K, int N, float* C, int ldc, bf16_t* H, int c, int G, int wv) {
    const int tid = ltid(wv), wid = tid >> 6, lane = tid & 63, r = lane & 31, h = lane >> 5;
    constexpr int TPW = 8 / KS;
    const int ntn = PAIR ? (N / 64) : (N / 32); const int ntiles = 8 * ntn;
    LAS float* red = (LAS float*)(lds + L_STAGE);
    for (int base = c * TPW; base < ntiles; base += G * TPW) {
        const int tile = base + wid / KS, kp = wid % KS; const bool act = tile < ntiles;
        f32x16 acc0, acc1;
#pragma unroll
        for (int i = 0; i < 16; ++i) { acc0[i] = 0.f; acc1[i] = 0.f; }
        int m0 = 0, n0 = 0;
        if (act) {
            const int tm = PAIR ? tile / ntn : tile % 8, tn = PAIR ? tile % ntn : tile / 8; m0 = tm * 32;
            if (PAIR) n0 = (tn >> 2) * 256 + (tn & 3) * 32; else n0 = tn * 32;
            const int klen = K / KS, kb = kp * klen;
            const bf16_t* ap = A + (size_t)(m0 + r) * lda + kb + 8 * h;
            const bf16_t* bp = Bt + (size_t)(n0 + r) * ldb + kb + 8 * h;
#pragma unroll 4
            for (int k = 0; k < klen; k += 16) {
                const bf16x8 a = *(const bf16x8*)(ap + k); const bf16x8 b = *(const bf16x8*)(bp + k);
                acc0 = MFMA32(a, b, acc0);
                if (PAIR) { const bf16x8 b2 = *(const bf16x8*)(bp + (size_t)128 * ldb + k); acc1 = MFMA32(a, b2, acc1); }
            }
        }
        if (KS > 1) {
#pragma unroll
            for (int i = 0; i < 16; ++i) red[(wid * 16 + i) * 64 + lane] = acc0[i];
            __syncthreads();
            if (act && kp == 0) {
#pragma unroll
                for (int i = 0; i < 16; ++i) { float s = 0.f;
#pragma unroll
                    for (int q = 0; q < KS; ++q) s += red[((wid + q) * 16 + i) * 64 + lane];
                    C[(size_t)(m0 + crow(i, h)) * ldc + n0 + r] = s; }
            }
            __syncthreads();
        } else if (act) {
            if (PAIR) {
                const int ch = (n0 >> 8) * 128 + (n0 & 127) + r;
#pragma unroll
                for (int i = 0; i < 16; ++i) { const float gt = acc0[i]; const float v = gt * sigmoidf_(gt) * acc1[i]; H[(size_t)(m0 + crow(i, h)) * ldc + ch] = (bf16_t)(pk_bf16(v, 0.f) & 0xffffu); }
            } else {
#pragma unroll
                for (int i = 0; i < 16; ++i) C[(size_t)(m0 + crow(i, h)) * ldc + n0 + r] = acc0[i];
            }
        }
    }
}

DI void transpose_tile(LAS float* T, const float* src, int ldsrc, int k0, int ncol0, bf16_t* dst, int lddst, int nrow0, int tid) {
#pragma unroll
    for (int i = 0; i < 2; ++i) { const int k = (tid >> 4) + 32 * i, n4 = tid & 15; const f32x4 v = __builtin_nontemporal_load((const f32x4*)(src + (size_t)(k0 + k) * ldsrc + ncol0 + n4 * 4));
        T[k * 65 + n4 * 4 + 0] = v[0]; T[k * 65 + n4 * 4 + 1] = v[1]; T[k * 65 + n4 * 4 + 2] = v[2]; T[k * 65 + n4 * 4 + 3] = v[3]; }
    __syncthreads();
    { const int n = tid >> 3, k8 = tid & 7; float v[8];
#pragma unroll
      for (int j = 0; j < 8; ++j) v[j] = T[(k8 * 8 + j) * 65 + n];
      u32x4 w; w.x = pk_bf16(v[0], v[1]); w.y = pk_bf16(v[2], v[3]); w.z = pk_bf16(v[4], v[5]); w.w = pk_bf16(v[6], v[7]);
      *(u32x4*)(dst + (size_t)(nrow0 + n) * lddst + k0 + k8 * 8) = w; }
    __syncthreads();
}
DI float wave_sum(float v) { v += __shfl_xor(v, 1); v += __shfl_xor(v, 2); v += __shfl_xor(v, 4); v += __shfl_xor(v, 8); v = xr_sum(v); v = xh_sum(v); return v; }
DI float wave_max(float v) { v = fmaxf(v, __shfl_xor(v, 1)); v = fmaxf(v, __shfl_xor(v, 2)); v = fmaxf(v, __shfl_xor(v, 4)); v = fmaxf(v, __shfl_xor(v, 8)); v = xr_max(v); v = xh_max(v); return v; }
template <bool RAW = false>
DI void norm_row(const float* x, const float* g, bf16_t* dst, int lane, bf16_t* raw = nullptr) {
    f32x4 v[4]; v[0] = __builtin_nontemporal_load((const f32x4*)(x + lane * 8)); v[1] = __builtin_nontemporal_load((const f32x4*)(x + lane * 8 + 4)); v[2] = __builtin_nontemporal_load((const f32x4*)(x + 512 + lane * 8)); v[3] = __builtin_nontemporal_load((const f32x4*)(x + 512 + lane * 8 + 4));
    float ss = 0.f;
#pragma unroll
    for (int i = 0; i < 4; ++i) ss += v[i][0] * v[i][0] + v[i][1] * v[i][1] + v[i][2] * v[i][2] + v[i][3] * v[i][3];
    ss = wave_sum(ss); const float rs = rsqrtf(ss * (1.0f / 1024.0f) + EPS);
    if (RAW) {
#pragma unroll
        for (int hh = 0; hh < 2; ++hh) { const f32x4 a = v[2 * hh], b = v[2 * hh + 1];
            u32x4 w; w.x = pk_bf16(a[0], a[1]); w.y = pk_bf16(a[2], a[3]); w.z = pk_bf16(b[0], b[1]); w.w = pk_bf16(b[2], b[3]); *(u32x4*)(raw + hh * 512 + lane * 8) = w; }
    }
#pragma unroll
    for (int hh = 0; hh < 2; ++hh) { const f32x4 g0 = *(const f32x4*)(g + hh * 512 + lane * 8), g1 = *(const f32x4*)(g + hh * 512 + lane * 8 + 4); const f32x4 a = v[2 * hh] * rs * g0, b = v[2 * hh + 1] * rs * g1;
        u32x4 w; w.x = pk_bf16(a[0], a[1]); w.y = pk_bf16(a[2], a[3]); w.z = pk_bf16(b[0], b[1]); w.w = pk_bf16(b[2], b[3]); *(u32x4*)(dst + hh * 512 + lane * 8) = w; }
}

DI void weight_tile(LAS unsigned char* lds, const Params& p, int ti, int wv) {
    const int tid = ltid(wv); unsigned char* ws = p.ws; LAS float* T = (LAS float*)(lds + L_STAGE);
        const float* src; int ldsrc, k0, ncol0, lddst, nrow0; bf16_t* dst;
        if (ti < 640) { const int kt = ti & 15, nb = ti >> 4; src = p.in[10]; ldsrc = 2560; k0 = kt * 64; dst = (bf16_t*)(ws + W_BT_IN); lddst = 1024; nrow0 = nb * 64;
            if (nb < 24) ncol0 = nb * 64; else { const int q = nb - 24, j = q >> 2, s = (q >> 1) & 1, hf = q & 1; ncol0 = 1536 + s * 512 + j * 128 + hf * 64; } }
        else if (ti < 1920) { const int q = ti - 640, wsel = q >> 8, t2 = q & 255, kt = t2 & 15, nb = t2 >> 4; const int idx[5] = {16, 20, 21, 22, 23};
            const size_t offs[5] = {W_BT_OUT, W_BT_MQ, W_BT_MK, W_BT_MV, W_BT_MO};
            src = p.in[wsel == 0 ? 16 : (wsel == 1 ? 20 : (wsel == 2 ? 21 : (wsel == 3 ? 22 : 23)))]; (void)idx;
            dst = (bf16_t*)(ws + (wsel == 0 ? W_BT_OUT : (wsel == 1 ? W_BT_MQ : (wsel == 2 ? W_BT_MK : (wsel == 3 ? W_BT_MV : W_BT_MO))))); (void)offs;
            ldsrc = 1024; k0 = kt * 64; ncol0 = nb * 64; lddst = 1024; nrow0 = nb * 64; }
        else if (ti < 3328) { const int q = ti - 1920, up = q >= 704 ? 1 : 0, t2 = q - up * 704, kt = t2 & 15, nb = t2 >> 4; src = p.in[up ? 27 : 26]; ldsrc = 2816; k0 = kt * 64; ncol0 = nb * 64;
            dst = (bf16_t*)(ws + W_BT_GU); lddst = 1024; nrow0 = (nb >> 1) * 256 + (nb & 1) * 64 + up * 128; }
        else { const int q = ti - 3328, nb = q & 15, kt = q >> 4; src = p.in[28]; ldsrc = 1024; k0 = kt * 64; ncol0 = nb * 64; dst = (bf16_t*)(ws + W_BT_DN); lddst = 2816; nrow0 = nb * 64; }
        transpose_tile(T, src, ldsrc, k0, ncol0, dst, lddst, nrow0, tid);
}

DI void phase_prep(LAS unsigned char* lds, const Params& p, int c, int G, int wv) {
    const int tid = ltid(wv), wid = tid >> 6, lane = tid & 63; unsigned char* ws = p.ws;
    LAS float* T = (LAS float*)(lds + L_STAGE);
    for (int tj = c; tj < 640 + 512; tj += G) { const int ti = tj < 640 ? tj : 640 + 512 + (tj - 640);
        const float* src; int ldsrc, k0, ncol0, lddst, nrow0; bf16_t* dst;
        if (ti < 640) { const int kt = ti & 15, nb = ti >> 4; src = p.in[10]; ldsrc = 2560; k0 = kt * 64; dst = (bf16_t*)(ws + W_BT_IN); lddst = 1024; nrow0 = nb * 64;
            if (nb < 24) ncol0 = nb * 64; else { const int q = nb - 24, j = q >> 2, s = (q >> 1) & 1, hf = q & 1; ncol0 = 1536 + s * 512 + j * 128 + hf * 64; } }
        else if (ti < 1920) { const int q = ti - 640, wsel = q >> 8, t2 = q & 255, kt = t2 & 15, nb = t2 >> 4; const int idx[5] = {16, 20, 21, 22, 23};
            const size_t offs[5] = {W_BT_OUT, W_BT_MQ, W_BT_MK, W_BT_MV, W_BT_MO};
            src = p.in[wsel == 0 ? 16 : (wsel == 1 ? 20 : (wsel == 2 ? 21 : (wsel == 3 ? 22 : 23)))]; (void)idx;
            dst = (bf16_t*)(ws + (wsel == 0 ? W_BT_OUT : (wsel == 1 ? W_BT_MQ : (wsel == 2 ? W_BT_MK : (wsel == 3 ? W_BT_MV : W_BT_MO))))); (void)offs;
            ldsrc = 1024; k0 = kt * 64; ncol0 = nb * 64; lddst = 1024; nrow0 = nb * 64; }
        else if (ti < 3328) { const int q = ti - 1920, up = q >= 704 ? 1 : 0, t2 = q - up * 704, kt = t2 & 15, nb = t2 >> 4; src = p.in[up ? 27 : 26]; ldsrc = 2816; k0 = kt * 64; ncol0 = nb * 64;
            dst = (bf16_t*)(ws + W_BT_GU); lddst = 1024; nrow0 = (nb >> 1) * 256 + (nb & 1) * 64 + up * 128; }
        else { const int q = ti - 3328, nb = q & 15, kt = q >> 4; src = p.in[28]; ldsrc = 1024; k0 = kt * 64; ncol0 = nb * 64; dst = (bf16_t*)(ws + W_BT_DN); lddst = 2816; nrow0 = nb * 64; }
        transpose_tile(T, src, ldsrc, k0, ncol0, dst, lddst, nrow0, tid);
    }
    for (int i = c * 512 + tid; i < 3 * 32768 / 4; i += G * 512) ((f32x4*)(ws + W_SS))[i] = (f32x4){0.f, 0.f, 0.f, 0.f};
    for (int row = c * 8 + wid; row < 33024 + 512; row += G * 8) {
        if (row < MP) norm_row<true>(p.in[0] + (size_t)row * DM, p.in[8], (bf16_t*)(ws + W_H) + (size_t)row * DM, lane, (bf16_t*)(ws + W_XR) + (size_t)row * DM);
        else if (row < 33024) norm_row(p.in[1] + (size_t)(row - MP) * DM, p.in[8], (bf16_t*)(ws + W_H) + (size_t)row * DM, lane);
        else norm_row(p.in[7] + (size_t)(row - 33024) * DM, p.in[19], (bf16_t*)(ws + W_MEMN) + (size_t)(row - 33024) * DM, lane);
    }
    { const size_t n4 = (size_t)16 * 496 * 128;
      for (size_t i = (size_t)c * 512 + tid; i < n4; i += (size_t)G * 512) { const size_t bs = i / (496 * 128), rem = i % (496 * 128);
          const size_t so = (bs * 512 + 16) * 512 + rem * 4, dof = bs * 512 * 512 + rem * 4;
          *(f32x4*)(p.out + O_AKS + dof) = *(const f32x4*)(p.in[2] + so); *(f32x4*)(p.out + O_AVS + dof) = *(const f32x4*)(p.in[3] + so); }
      const size_t m4 = (size_t)16 * 14 * 128;
      for (size_t i = (size_t)c * 512 + tid; i < m4; i += (size_t)G * 512) { const size_t bs = i / (14 * 128), rem = i % (14 * 128);
          *(f32x4*)(p.out + O_CVS + bs * 30 * 512 + rem * 4) = *(const f32x4*)(p.in[4] + (bs * 30 + 16) * 512 + rem * 4); } }
}

DI bf16x8 pack8(const f32x16& x, int s) { u32x4 w; w.x = pk_bf16(x[8 * s], x[8 * s + 1]); w.y = pk_bf16(x[8 * s + 2], x[8 * s + 3]); w.z = pk_bf16(x[8 * s + 4], x[8 * s + 5]); w.w = pk_bf16(x[8 * s + 6], x[8 * s + 7]); return __builtin_bit_cast(bf16x8, w); }

DI void attn_item(const Params& p, LAS unsigned char* lds, int b, int c, int wv) {
    const int tid = ltid(wv), hd = tid >> 6, lane = tid & 63, r = lane & 31, h = lane >> 5; unsigned char* ws = p.ws;
    const bf16_t* Q = (const bf16_t*)(ws + W_Q); const bf16_t* Kp = (const bf16_t*)(ws + W_K); const bf16_t* VT = (const bf16_t*)(ws + W_VT);
    const LAS float* bl = (const LAS float*)(lds + L_BIAS) + hd * 257;
    const size_t qrow0 = (size_t)b * TP + c * 64;
    bf16x8 qf[2][4];
#pragma unroll
    for (int qb = 0; qb < 2; ++qb)
#pragma unroll
        for (int ds = 0; ds < 4; ++ds) qf[qb][ds] = *(const bf16x8*)(Q + (qrow0 + qb * 32 + r) * 512 + hd * 64 + ds * 16 + 8 * h);
    f32x16 O[2][2];
#pragma unroll
    for (int a = 0; a < 2; ++a)
#pragma unroll
        for (int q = 0; q < 2; ++q)
#pragma unroll
            for (int i = 0; i < 16; ++i) O[a][q][i] = 0.f;
    float mrow[2] = {0.f, 0.f}, lrow[2] = {0.f, 0.f};
    const float bconst = bl[256];
    const int kb0 = c >= 8 ? 0 : (8 - c) * 2;
    const bf16_t* kbase = Kp + ((size_t)b * TP + (c - 8) * 64 + r) * 512 + hd * 64 + 8 * h;
    const bf16_t* vbase = VT + ((size_t)(b * 8 + hd) * 64 + r) * TP + (c - 8) * 64 + 8 * h;
    bf16x8 kfn[4], vfn[2][2];
#pragma unroll
    for (int ds = 0; ds < 4; ++ds) kfn[ds] = *(const bf16x8*)(kbase + (size_t)kb0 * 32 * 512 + ds * 16);
#pragma unroll
    for (int db = 0; db < 2; ++db)
#pragma unroll
        for (int s = 0; s < 2; ++s) vfn[db][s] = *(const bf16x8*)(vbase + (size_t)db * 32 * TP + kb0 * 32 + s * 16);
    for (int kbi = kb0; kbi < 18; ++kbi) {
        bf16x8 kf[4], vf[2][2];
#pragma unroll
        for (int ds = 0; ds < 4; ++ds) kf[ds] = kfn[ds];
#pragma unroll
        for (int db = 0; db < 2; ++db)
#pragma unroll
            for (int s = 0; s < 2; ++s) vf[db][s] = vfn[db][s];
        if (kbi + 1 < 18) {
#pragma unroll
            for (int ds = 0; ds < 4; ++ds) kfn[ds] = *(const bf16x8*)(kbase + (size_t)(kbi + 1) * 32 * 512 + ds * 16);
#pragma unroll
            for (int db = 0; db < 2; ++db)
#pragma unroll
                for (int s = 0; s < 2; ++s) vfn[db][s] = *(const bf16x8*)(vbase + (size_t)db * 32 * TP + (kbi + 1) * 32 + s * 16);
        }
        const bool first = kbi == kb0;
#pragma unroll
        for (int qb = 0; qb < 2; ++qb) {
            f32x16 S; const float c0 = (kbi >= 12 ? 0.f : bconst) - mrow[qb];
#pragma unroll
            for (int i = 0; i < 16; ++i) S[i] = c0;
#pragma unroll
            for (int ds = 0; ds < 4; ++ds) S = MFMA32(kf[ds], qf[qb][ds], S);
            if (kbi >= 12) {
#pragma unroll
                for (int i = 0; i < 16; ++i) { int idx = qb * 32 + r + 640 - kbi * 32 - crow(i, h); idx = idx < 0 ? 0 : (idx > 256 ? 256 : idx); S[i] += bl[idx]; }
            }
            float mx = fmaxf(fmaxf(fmaxf(S[0], S[1]), fmaxf(S[2], S[3])), fmaxf(fmaxf(S[4], S[5]), fmaxf(S[6], S[7])));
            mx = fmaxf(mx, fmaxf(fmaxf(fmaxf(S[8], S[9]), fmaxf(S[10], S[11])), fmaxf(fmaxf(S[12], S[13]), fmaxf(S[14], S[15]))));
            mx = xh_max(mx);
            if (first || __builtin_amdgcn_ballot_w64(mx > 8.0f) != 0ull) {
                const float d = (first || mx > 8.0f) ? mx : 0.f; const float alpha = fast_exp2(-d); mrow[qb] += d; lrow[qb] *= alpha;
#pragma unroll
                for (int i = 0; i < 16; ++i) S[i] -= d;
#pragma unroll
                for (int db = 0; db < 2; ++db)
#pragma unroll
                    for (int i = 0; i < 16; ++i) O[db][qb][i] *= alpha;
            }
            float rs = 0.f;
#pragma unroll
            for (int i = 0; i < 16; ++i) { const float pv = fast_exp2(S[i]); S[i] = pv; rs += pv; }
            lrow[qb] += rs;
#pragma unroll
            for (int s = 0; s < 2; ++s) { const bf16x8 pf = pack8(S, s);
#pragma unroll
                for (int db = 0; db < 2; ++db) O[db][qb] = MFMA32(vf[db][s], pf, O[db][qb]); }
        }
    }
    bf16_t* MIX = (bf16_t*)(ws + W_MIX);
#pragma unroll
    for (int qb = 0; qb < 2; ++qb) {
        const float l = xh_sum(lrow[qb]); const float inv = 1.0f / l;
#pragma unroll
        for (int db = 0; db < 2; ++db)
#pragma unroll
            for (int g4 = 0; g4 < 4; ++g4) { u32x2 w; w.x = pk_bf16(O[db][qb][4 * g4] * inv, O[db][qb][4 * g4 + 1] * inv); w.y = pk_bf16(O[db][qb][4 * g4 + 2] * inv, O[db][qb][4 * g4 + 3] * inv);
                *(u32x2*)(MIX + (qrow0 + qb * 32 + r) * 1024 + hd * 64 + db * 32 + 8 * g4 + 4 * h) = w; }
    }
}

DI void wave_reduce32(float (&v)[32], int lane) {
#pragma unroll
    for (int s = 0; s < 5; ++s) { const int half = 16 >> s; const unsigned mk = (lane & half) ? 0xffffffffu : 0u;
#pragma unroll
        for (int k = 0; k < half; ++k) { const unsigned ua = __float_as_uint(v[k]), ub = __float_as_uint(v[k + half]);
            const float keep = __uint_as_float((ub & mk) | (ua & ~mk)); const float send = __uint_as_float((ua & mk) | (ub & ~mk)); v[k] = keep + __shfl_xor(send, half); }
        __builtin_amdgcn_sched_barrier(0); }
    v[0] = xh_sum(v[0]);
}

DI void conv_item(const Params& p, LAS unsigned char* lds, int b, int c, int wv) {
    const int tid = ltid(wv), wid = tid >> 6, lane = tid & 63; unsigned char* ws = p.ws;
    const bf16_t* U = (const bf16_t*)(ws + W_U); const int t0 = c * 64;
    for (int idx = tid; idx < 94 * 64; idx += 512) { const int rr = idx >> 6, seg = idx & 63; const int t = t0 - 30 + rr; u32x4 v = (u32x4){0u, 0u, 0u, 0u};
        if (t >= 0) v = *(const u32x4*)(U + ((size_t)b * TP + t) * 512 + seg * 8); *(LAS u32x4*)(lds + rr * 1024 + seg * 16) = v; }
    __syncthreads();
    const int cp = tid & 255, th = tid >> 8; const int zz = lzero();
    LAS float* part = (LAS float*)(lds + 98304);
    LAS f32x2* stats = (LAS f32x2*)(lds + 98304 + 2048);
    float cw0[31], cw1[31];
#pragma unroll
    for (int w = 0; w < 31; ++w) { const f32x2 t2 = *(const f32x2*)(p.in[12] + zz + w * 512 + 2 * cp); cw0[w] = t2.x; cw1[w] = t2.y; }
    const f32x2 cb = *(const f32x2*)(p.in[13] + zz + 2 * cp);
    const f32x2 lg = *(const f32x2*)(p.in[14] + zz + 2 * cp), lb = *(const f32x2*)(p.in[15] + zz + 2 * cp);
    bf16_t* MIX = (bf16_t*)(ws + W_MIX);
#pragma unroll 1
    for (int ps = 0; ps < 2; ++ps) {
        const int tb = th * 32 + ps * 16;
        float a0[16], a1[16];
#pragma unroll
        for (int t = 0; t < 16; ++t) { a0[t] = cb.x; a1[t] = cb.y; }
#pragma unroll
        for (int rr = 0; rr < 46; ++rr) { if ((rr & 7) == 0) asm volatile("" ::: "memory");
            const unsigned w = *(const LAS unsigned*)(lds + (tb + rr) * 1024 + cp * 4); const float v0 = bf_lo(w), v1 = bf_hi(w);
#pragma unroll
            for (int t = 0; t < 16; ++t) { const int wi = rr - t; if (wi >= 0 && wi <= 30) { a0[t] += v0 * cw0[wi]; a1[t] += v1 * cw1[wi]; } } }
        { float v[32];
#pragma unroll
          for (int t = 0; t < 16; ++t) { v[t] = a0[t] + a1[t]; v[16 + t] = a0[t] * a0[t] + a1[t] * a1[t]; }
          wave_reduce32(v, lane); if (lane < 32) part[wid * 32 + lane] = v[0]; }
        __syncthreads();
        if (tid < 32) { const int hh = tid >> 4, t = tid & 15; float s1 = 0.f, s2 = 0.f;
#pragma unroll
            for (int w = 0; w < 4; ++w) { s1 += part[(hh * 4 + w) * 32 + t]; s2 += part[(hh * 4 + w) * 32 + 16 + t]; }
            const float mean = s1 * (1.0f / 512.0f); const float var = fmaxf(s2 * (1.0f / 512.0f) - mean * mean, 0.f); stats[tid] = (f32x2){mean, rsqrtf(var + EPS)}; }
        __syncthreads();
        bf16_t* mp = MIX + ((size_t)b * TP + t0 + tb) * 1024 + 512 + 2 * cp; asm volatile("" : "+v"(mp));
#pragma unroll
        for (int t = 0; t < 16; ++t) { const f32x2 st = stats[th * 16 + t]; const float y0 = (a0[t] - st.x) * st.y * lg.x + lb.x, y1 = (a1[t] - st.x) * st.y * lg.y + lb.y;
            *(unsigned*)(mp + t * 1024) = pk_bf16(y0 * sigmoidf_(y0), y1 * sigmoidf_(y1)); }
        __syncthreads();
    }
}

template <int DH, int NK, bool BAND, int NQ>
DI void sample_attn(const Params& p, LAS unsigned char* lds, int bs, int hd, int q0, int wv) {
    const int tid = ltid(wv), wid = tid >> 6, lane = tid & 63; unsigned char* ws = p.ws;
    LAS float* qs = (LAS float*)(lds + L_STAGE);
    LAS float* sc = (LAS float*)(lds + L_STAGE + 16 * DH * 4);
    const float* qsrc = BAND ? (const float*)(ws + W_SPROJ) : (const float*)(ws + W_SQM); const int ldq = BAND ? 2560 : 1024;
    const float qscale = (BAND ? 0.125f : 0.0625f) * LOG2E;
    for (int i = tid; i < NQ * DH; i += 512) { const int qi = i / DH, d = i % DH; qs[i] = qsrc[(size_t)(bs * 16 + q0 + qi) * ldq + hd * DH + d] * qscale; }
    __syncthreads();
    constexpr int TPK = BAND ? 1 : 2; constexpr int DPT = DH / TPK;
    for (int j0 = 0; j0 < NK; j0 += 512 / TPK) {
        const int j = j0 + tid / TPK, part = tid % TPK;
        if (j < NK) {
            const float* kp;
            if (BAND) kp = j < 512 ? p.in[2] + (((size_t)bs * 512 + j) * 8 + hd) * 64 : (const float*)(ws + W_SPROJ) + (size_t)(bs * 16 + (j - 512)) * 2560 + 512 + hd * 64;
            else kp = p.in[5] + (((size_t)bs * 256 + j) * 4 + hd) * 256 + part * DPT;
            float a[NQ];
#pragma unroll
            for (int q = 0; q < NQ; ++q) a[q] = 0.f;
            for (int d = 0; d < DPT; d += 4) { const f32x4 kv = *(const f32x4*)(kp + d);
#pragma unroll
                for (int q = 0; q < NQ; ++q) { const f32x4 qv = *(const LAS f32x4*)(qs + q * DH + part * DPT + d); a[q] += kv[0] * qv[0] + kv[1] * qv[1] + kv[2] * qv[2] + kv[3] * qv[3]; } }
            if (TPK == 2) {
#pragma unroll
                for (int q = 0; q < NQ; ++q) a[q] += __shfl_xor(a[q], 1);
            }
            if (BAND) {
#pragma unroll
                for (int q = 0; q < NQ; ++q) { int idx = q0 + q + 640 - j; idx = idx < 0 ? 0 : (idx > 256 ? 256 : idx); a[q] += ((const LAS float*)(lds + L_BIAS))[hd * 257 + idx]; }
            }
            if (part == 0) {
#pragma unroll
                for (int q = 0; q < NQ; q += 4) *(LAS f32x4*)(sc + j * 16 + q) = (f32x4){a[q], a[q + 1], a[q + 2], a[q + 3]};
            }
        }
    }
    __syncthreads();
#pragma unroll
    for (int qq = 0; qq < 2; ++qq) { const int q = wid * 2 + qq; if (q >= NQ) continue; float mx = -3.0e38f;
        for (int j = lane; j < NK; j += 64) mx = fmaxf(mx, sc[j * 16 + q]);
        mx = wave_max(mx); float s = 0.f;
        for (int j = lane; j < NK; j += 64) { const float pv = fast_exp2(sc[j * 16 + q] - mx); sc[j * 16 + q] = pv; s += pv; }
        s = wave_sum(s); const float inv = 1.0f / s;
        for (int j = lane; j < NK; j += 64) sc[j * 16 + q] *= inv; }
    __syncthreads();
    { constexpr int QPT = NQ * DH / 512; const int d = tid % DH, qg = tid / DH; float o[QPT];
#pragma unroll
      for (int q = 0; q < QPT; ++q) o[q] = 0.f;
      const float* vb = BAND ? p.in[3] + (((size_t)bs * 512) * 8 + hd) * 64 + d : p.in[6] + (((size_t)bs * 256) * 4 + hd) * 256 + d;
      constexpr int NKC = BAND ? 512 : 256; constexpr int VST = BAND ? 512 : 1024;
      for (int j0 = 0; j0 < NKC; j0 += 16) { float vv[16];
#pragma unroll
          for (int jj = 0; jj < 16; ++jj) vv[jj] = vb[(size_t)(j0 + jj) * VST];
#pragma unroll
          for (int jj = 0; jj < 16; ++jj)
#pragma unroll
              for (int q = 0; q < QPT; ++q) o[q] += sc[(j0 + jj) * 16 + qg * QPT + q] * vv[jj]; }
      if (BAND) {
#pragma unroll
          for (int jj = 0; jj < 16; ++jj) { const float v = ((const float*)(ws + W_SPROJ))[(size_t)(bs * 16 + jj) * 2560 + 1024 + hd * 64 + d];
#pragma unroll
              for (int q = 0; q < QPT; ++q) o[q] += sc[(512 + jj) * 16 + qg * QPT + q] * v; } }
      bf16_t* dst = BAND ? (bf16_t*)(ws + W_SMIX) : (bf16_t*)(ws + W_SOM);
#pragma unroll
      for (int q = 0; q < QPT; ++q) dst[(size_t)(bs * 16 + q0 + qg * QPT + q) * 1024 + hd * DH + d] = (bf16_t)(pk_bf16(o[q], 0.f) & 0xffffu); }
    __syncthreads();
}

DI void sample_conv(const Params& p, LAS unsigned char* lds, int bs, int wv) {
    const int tid = ltid(wv), wid = tid >> 6, lane = tid & 63, ch = tid; unsigned char* ws = p.ws;
    const int zz = lzero(); const float* proj = (const float*)(ws + W_SPROJ) + zz;
    LAS float* ext = (LAS float*)(lds + L_STAGE);
    for (int i = 0; i < 30; ++i) ext[i * 512 + ch] = p.in[4][((size_t)bs * 30 + i) * 512 + ch];
    const int cv = 1536 + 256 * (ch >> 7) + (ch & 127);
    for (int t = 0; t < 16; ++t) { const float val = proj[(size_t)(bs * 16 + t) * 2560 + cv], gt = proj[(size_t)(bs * 16 + t) * 2560 + cv + 128]; const float uu = val * sigmoidf_(gt); ext[(30 + t) * 512 + ch] = uu;
        p.out[O_CVS + ((size_t)bs * 30 + 14 + t) * 512 + ch] = uu;
        p.out[O_AKS + ((size_t)bs * 512 + 496 + t) * 512 + ch] = proj[(size_t)(bs * 16 + t) * 2560 + 512 + ch];
        p.out[O_AVS + ((size_t)bs * 512 + 496 + t) * 512 + ch] = proj[(size_t)(bs * 16 + t) * 2560 + 1024 + ch]; }
    float cw[31];
#pragma unroll
    for (int w = 0; w < 31; ++w) cw[w] = (p.in[12] + zz)[w * 512 + ch];
    const float cb = (p.in[13] + zz)[ch];
    float cc[16];
#pragma unroll
    for (int t = 0; t < 16; ++t) { float a = cb;
#pragma unroll
        for (int w = 0; w < 31; ++w) a += ext[(t + w) * 512 + ch] * cw[w];
        cc[t] = a; asm volatile("" ::: "memory"); }
    LAS float* part = (LAS float*)(lds + 98304); LAS f32x2* stats = (LAS f32x2*)(lds + 98304 + 2048);
    { float v[32];
#pragma unroll
      for (int t = 0; t < 32; ++t) v[t] = t < 16 ? cc[t & 15] : cc[t & 15] * cc[t & 15];
      wave_reduce32(v, lane); if (lane < 32) part[wid * 32 + lane] = v[0]; }
    __syncthreads();
    if (tid < 16) { float s1 = 0.f, s2 = 0.f;
#pragma unroll
        for (int w = 0; w < 8; ++w) { s1 += part[w * 32 + tid]; s2 += part[w * 32 + 16 + tid]; }
        const float mean = s1 * (1.0f / 512.0f); const float var = fmaxf(s2 * (1.0f / 512.0f) - mean * mean, 0.f); stats[tid] = (f32x2){mean, rsqrtf(var + EPS)}; }
    __syncthreads();
    const float lg = (p.in[14] + zz)[ch], lb = (p.in[15] + zz)[ch];
#pragma unroll
    for (int t = 0; t < 16; ++t) { const f32x2 st = stats[t]; const float y = (cc[t] - st.x) * st.y * lg + lb;
        ((bf16_t*)(ws + W_SMIX))[(size_t)(bs * 16 + t) * 1024 + 512 + ch] = (bf16_t)(pk_bf16(y * sigmoidf_(y), 0.f) & 0xffffu); }
    __syncthreads();
}

template <bool SAMPLE>
DI void e_row(const Params& p, int row, int which, int lane, float* dummy) {
    unsigned char* ws = p.ws;
    const float* gpost = p.in[which == 0 ? 9 : (which == 1 ? 18 : 25)];
    const float* gpre = p.in[which == 0 ? 17 : 24];
    const size_t grow = (size_t)(SAMPLE ? MP + row : row);
    bf16_t* xr = (bf16_t*)(ws + W_XR) + grow * DM;
    bf16_t* xr_rd = xr; bf16_t* xr_wr = xr;
    if (SAMPLE) { bf16_t* xb = (bf16_t*)(ws + W_XRS2) + (size_t)row * DM; if (which == 1) xr_wr = xb; if (which == 2) xr_rd = xb; }
    f32x4 y[4]; float rs;
    if (!SAMPLE) {
        const bf16_t* yp = (const bf16_t*)(ws + W_Y) + (size_t)row * DM;
#pragma unroll
        for (int hh = 0; hh < 2; ++hh) { const u32x4 w = *(const u32x4*)(yp + hh * 512 + lane * 8);
            y[2 * hh] = (f32x4){bf_lo(w.x), bf_hi(w.x), bf_lo(w.y), bf_hi(w.y)}; y[2 * hh + 1] = (f32x4){bf_lo(w.z), bf_hi(w.z), bf_lo(w.w), bf_hi(w.w)}; }
        const float ss = ((const float*)(ws + W_SS))[which * 32768 + row]; rs = rsqrtf(ss * (1.0f / 1024.0f) + EPS);
    } else {
        const float* yp = (const float*)(ws + W_SY) + (size_t)row * DM; float ss = 0.f;
#pragma unroll
        for (int hh = 0; hh < 2; ++hh) { y[2 * hh] = *(const f32x4*)(yp + hh * 512 + lane * 8); y[2 * hh + 1] = *(const f32x4*)(yp + hh * 512 + lane * 8 + 4); }
#pragma unroll
        for (int i = 0; i < 4; ++i) ss += y[i][0] * y[i][0] + y[i][1] * y[i][1] + y[i][2] * y[i][2] + y[i][3] * y[i][3];
        ss = wave_sum(ss); rs = rsqrtf(ss * (1.0f / 1024.0f) + EPS);
    }
    f32x4 xn[4]; float s2 = 0.f;
    if (which == 0) {
        const float* xin = (SAMPLE ? p.in[1] : p.in[0]) + (size_t)row * DM;
#pragma unroll
        for (int i = 0; i < 4; ++i) xn[i] = *(const f32x4*)(xin + (i >> 1) * 512 + lane * 8 + (i & 1) * 4);
    } else {
#pragma unroll
        for (int hh = 0; hh < 2; ++hh) { const u32x4 w = *(const u32x4*)(xr_rd + hh * 512 + lane * 8);
            xn[2 * hh] = (f32x4){bf_lo(w.x), bf_hi(w.x), bf_lo(w.y), bf_hi(w.y)}; xn[2 * hh + 1] = (f32x4){bf_lo(w.z), bf_hi(w.z), bf_lo(w.w), bf_hi(w.w)}; }
    }
#pragma unroll
    for (int i = 0; i < 4; ++i) { const int col = (i >> 1) * 512 + lane * 8 + (i & 1) * 4; const f32x4 gv = *(const f32x4*)(gpost + col);
        xn[i] = xn[i] + y[i] * rs * gv; s2 += xn[i][0] * xn[i][0] + xn[i][1] * xn[i][1] + xn[i][2] * xn[i][2] + xn[i][3] * xn[i][3]; }
    if (which == 2) {
        float* xout = (SAMPLE ? p.out + O_YS : p.out + O_YP) + (size_t)row * DM;
#pragma unroll
        for (int i = 0; i < 4; ++i) *(f32x4*)(xout + (i >> 1) * 512 + lane * 8 + (i & 1) * 4) = xn[i];
    } else {
        bf16_t* xw = dummy ? (bf16_t*)dummy + grow * DM : xr_wr;
#pragma unroll
        for (int hh = 0; hh < 2; ++hh) { const f32x4 a = xn[2 * hh], b = xn[2 * hh + 1];
            u32x4 w; w.x = pk_bf16(a[0], a[1]); w.y = pk_bf16(a[2], a[3]); w.z = pk_bf16(b[0], b[1]); w.w = pk_bf16(b[2], b[3]); *(u32x4*)(xw + hh * 512 + lane * 8) = w; }
        s2 = wave_sum(s2); const float r2 = rsqrtf(s2 * (1.0f / 1024.0f) + EPS);
        bf16_t* hp = (bf16_t*)(ws + W_H) + grow * DM;
#pragma unroll
        for (int hh = 0; hh < 2; ++hh) { const int col = hh * 512 + lane * 8; const f32x4 g0 = *(const f32x4*)(gpre + col), g1 = *(const f32x4*)(gpre + col + 4); const f32x4 a = xn[2 * hh] * r2 * g0, b = xn[2 * hh + 1] * r2 * g1;
            u32x4 w; w.x = pk_bf16(a[0], a[1]); w.y = pk_bf16(a[2], a[3]); w.z = pk_bf16(b[0], b[1]); w.w = pk_bf16(b[2], b[3]); *(u32x4*)(hp + col) = w; }
    }
}
DI void sample_e_block(const Params& p, int which, int tm, int wv) {
    const int tid = ltid(wv), wid = tid >> 6, lane = tid & 63;
#pragma unroll 1
    for (int i = 0; i < 4; ++i) e_row<true>(p, tm * 32 + wid * 4 + i, which, lane, nullptr);
}
DI void phase_e(const Params& p, int which, int c, int G, int wv, float* dummy) {
    const int tid = ltid(wv), wid = tid >> 6, lane = tid & 63;
    for (int row = c * 8 + wid; row < MP + MS; row += G * 8) { if (row < MP) e_row<false>(p, row, which, lane, dummy); else e_row<true>(p, row - MP, which, lane, dummy); }
}

#define XB_TMO      128
#define XB_XCNT(j)  (256  + 64 * (j))
#define XB_XSUB(j)  (1280 + 64 * (j))
#define XB_XGEN(j)  (2304 + 64 * (j))
#define XB_TOP      3328
#define XB_TOPGEN   3392
#define XB_SPIN_CAP (1u << 22)
DI unsigned xb_ld(unsigned* p) { return __hip_atomic_load(p, __ATOMIC_RELAXED, __HIP_MEMORY_SCOPE_AGENT); }
DI unsigned xb_add(unsigned* p, unsigned v) { return __hip_atomic_fetch_add(p, v, __ATOMIC_RELAXED, __HIP_MEMORY_SCOPE_AGENT); }
DI unsigned xb_xcc_id() { return (unsigned)__builtin_amdgcn_s_getreg((3 << 11) | 20) & 0xFu; }
#define XB_SPIN(cond, bar) do { unsigned _sp = 0; while (cond) { __builtin_amdgcn_s_sleep(1); \
    if ((++_sp & 255u) == 0u) { if (xb_ld(&(bar)[XB_TMO])) break; if (_sp > XB_SPIN_CAP) { atomicAdd(&(bar)[XB_TMO], 1u); break; } } } } while (0)
DI void xcd_barrier_complete(unsigned* bar, unsigned x, unsigned& nloc, unsigned& nx) {
    const unsigned Gn = gridDim.x; unsigned sum, cnt, mine, sp = 0u;
    for (;;) { sum = 0u; cnt = 0u; mine = 0u;
#pragma unroll
        for (unsigned j = 0; j < 16; ++j) { const unsigned cc = xb_ld(&bar[XB_XCNT(j)]); sum += cc; cnt += (cc > 0u) ? 1u : 0u; mine = (j == x) ? cc : mine; }
        if (sum == Gn) break;
        __builtin_amdgcn_s_sleep(1);
        if ((++sp & 255u) == 0u) { if (xb_ld(&bar[XB_TMO])) break; if (sp > XB_SPIN_CAP) { atomicAdd(&bar[XB_TMO], 1u); break; } } }
    nloc = mine > 0u ? mine : 1u; nx = cnt > 0u ? cnt : 1u;
}
DI void gbar(unsigned* bar, const unsigned x, volatile LAS unsigned* st, int wv) {
    const int tid = ltid(wv);
    asm volatile("s_waitcnt vmcnt(0)" ::: "memory");
    __syncthreads();
    if (tid == 0) {
        __builtin_amdgcn_s_waitcnt(0);
        unsigned nloc = st[0], nx = st[1];
        if (nloc == 0u) { xcd_barrier_complete(bar, x, nloc, nx); st[0] = nloc; st[1] = nx; }
        const unsigned old = xb_add(&bar[XB_XSUB(x)], 1u);
        const unsigned gen = old / nloc;
        if (old + 1u == (gen + 1u) * nloc) {
            __builtin_amdgcn_fence(__ATOMIC_RELEASE, "agent");
            asm volatile("s_waitcnt vmcnt(0)" ::: "memory");
            const unsigned og = xb_add(&bar[XB_TOP], 1u);
            const unsigned tg = og / nx;
            if (og + 1u == (tg + 1u) * nx) xb_add(&bar[XB_TOPGEN], 1u);
            else XB_SPIN(xb_ld(&bar[XB_TOPGEN]) == tg, bar);
            __builtin_amdgcn_fence(__ATOMIC_ACQUIRE, "agent");
            xb_add(&bar[XB_XGEN(x)], 1u);
            asm volatile("s_waitcnt vmcnt(0)" ::: "memory");
        } else {
            XB_SPIN(xb_ld(&bar[XB_XGEN(x)]) == gen, bar);
            __builtin_amdgcn_fence(__ATOMIC_ACQUIRE, "agent");
            asm volatile("s_waitcnt vmcnt(0)" ::: "memory");
        }
    }
    __syncthreads();
}

__global__ void __launch_bounds__(512, 2) mega_fwd(Params p) {
    extern __shared__ __attribute__((aligned(16))) unsigned char smem[];
    LAS unsigned char* lds = (LAS unsigned char*)smem;
    cg::grid_group grid = cg::this_grid();
    const int wv = __builtin_amdgcn_readfirstlane((int)(threadIdx.x >> 6));
    const int G = gridDim.x, c = blockIdx.x; const int tid = ltid(wv); unsigned char* ws = p.ws;
#if !N_LAUNCH_PER_PHASE
    volatile LAS unsigned* xst = (volatile LAS unsigned*)(lds + L_MISC + 64);
    unsigned* xbar = (unsigned*)(ws + W_XBAR); const unsigned xcc = xb_xcc_id();
    if (tid < 2) xst[tid] = 0u;
    if (tid == 0) (void)xb_add(&xbar[XB_XCNT(xcc)], 1u);
    if (p.ph_hi > 1000) grid.sync();
#endif
    const bf16_t* H = (const bf16_t*)(ws + W_H); const bf16_t* HS = H + (size_t)MP * DM;
    float* SS = (float*)(ws + W_SS);
#define PH_BEGIN(k) if ((k) >= p.ph_lo && (k) < p.ph_hi) { if ((k) > p.ph_lo) gbar(xbar, xcc, xst, wv); _Pragma("unroll 1") for (int rep = 0; rep <= ((DUP_MASK >> (k)) & 1); ++rep) { if (DUP_BAR && rep) gbar(xbar, xcc, xst, wv);
#define PH_END } }
    PH_BEGIN(0) phase_prep(lds, p, c, G, wv); PH_END
#ifdef EXTRA_BAR
    for (int xb = 0; xb < EXTRA_BAR; ++xb) gbar(xbar, xcc, xst, wv);
#endif
    PH_BEGIN(1) {
            small_gemm<2, false>(lds, HS, 1024, (const bf16_t*)(ws + W_BT_IN), 1024, 1024, 2560, (float*)(ws + W_SPROJ), 2560, nullptr, c, G, wv);
            GemmDesc g{H, (const bf16_t*)(ws + W_BT_IN), nullptr, 1024, 1024, 1024, 128, 10, 0}; EpiArgs e{nullptr, 0, 1.f, nullptr, 0};
            gemm_phase<EPI_G1>(lds, p, g, e, c, G, wv); } PH_END
    PH_BEGIN(2) {
            { GemmDesc g{(const bf16_t*)(ws + W_MEMN), (const bf16_t*)(ws + W_BT_MK), (const bf16_t*)(ws + W_BT_MV), 1024, 1024, 1024, 0, 0, 3}; EpiArgs e{nullptr, 0, 1.f, nullptr, 0};
              gemm_phase<EPI_KV>(lds, p, g, e, c, G, wv); }
            for (int i = tid; i < 8 * 257; i += 512) ((LAS float*)(lds + L_BIAS))[i] = p.in[11][i] * LOG2E;
            __syncthreads();
            LAS int* slot = (LAS int*)(lds + L_MISC);
#define DYN_LOOP(ctrword, nitems, body) for (;;) { if (tid == 0) slot[0] = (int)atomicAdd((unsigned*)(ws + W_CTL) + (ctrword) + rep * 64, 1u); __syncthreads(); const int it = slot[0]; __syncthreads(); if (it >= (nitems)) break; body; }
#define DYN_LOOP_AHEAD(ctrword, nitems, body) { unsigned* _ctr = (unsigned*)(ws + W_CTL) + (ctrword) + rep * 64; int _nx = 0; if (tid == 0) _nx = (int)atomicAdd(_ctr, 1u); \
    for (;;) { if (tid == 0) slot[0] = _nx; __syncthreads(); const int it = slot[0]; __syncthreads(); if (it >= (nitems)) break; \
        if (tid == 0) _nx = (int)atomicAdd(_ctr, 1u);     \
        body; } }
            DYN_LOOP(48, 16, sample_conv(p, lds, it, wv))
            DYN_LOOP(32, 128, (sample_attn<64, 528, true, 16>(p, lds, it >> 3, it & 7, 0, wv)))
            for (int xq = 0; xq < 8; ++xq) { const int xc = (c + xq) & 7;
                DYN_LOOP(2 + xc, 64, attn_item(p, lds, (xc * 64 + it) >> 8, (xc * 64 + it) & 255, wv)) }
            DYN_LOOP(16, 512, conv_item(p, lds, it >> 8, it & 255, wv))
            DYN_LOOP_AHEAD(80, 1440, { for (int q8 = 0; q8 < 2; ++q8) { const int tq = it * 2 + q8; weight_tile(lds, p, tq < 512 ? 640 + tq : 1664 + (tq - 512), wv); } })
            } PH_END
    PH_BEGIN(3) {
            small_gemm<8, false>(lds, (const bf16_t*)(ws + W_SMIX), 1024, (const bf16_t*)(ws + W_BT_OUT), 1024, 1024, 1024, (float*)(ws + W_SY), 1024, nullptr, c, G, wv);
            GemmDesc g{(const bf16_t*)(ws + W_MIX), (const bf16_t*)(ws + W_BT_OUT), nullptr, 1024, 1024, 1024, 128, 4, 0}; EpiArgs e{nullptr, 1024, 1.f, nullptr, 0};
            gemm_phase<EPI_YN>(lds, p, g, e, c, G, wv); } PH_END
    PH_BEGIN(4) {
            for (int base = c; base < 256; base += G) sample_e_block(p, 0, base % 8, wv);
            __syncthreads();
            small_gemm<8, false>(lds, HS, 1024, (const bf16_t*)(ws + W_BT_MQ), 1024, 1024, 1024, (float*)(ws + W_SQM), 1024, nullptr, c, G, wv);
            { const int tid = ltid(wv); asm volatile("s_waitcnt vmcnt(0)" ::: "memory"); __syncthreads();
              if (tid == 0) { __builtin_amdgcn_fence(__ATOMIC_RELEASE, "agent"); asm volatile("s_waitcnt vmcnt(0)" ::: "memory"); unsigned nt = 0; for (int base = c; base < 256; base += G) ++nt;
                  __hip_atomic_fetch_add((unsigned*)(ws + W_CTL) + 640, nt, __ATOMIC_RELAXED, __HIP_MEMORY_SCOPE_AGENT); } }
            { GemmDesc g{H, (const bf16_t*)(ws + W_BT_MQ), nullptr, 1024, 1024, 1024, 128, 4, 0}; EpiArgs e{(bf16_t*)(ws + W_QM), 1024, 0.0625f * LOG2E, nullptr, 0};
              gemm_phase<EPI_BF>(lds, p, g, e, c, G, wv); }
            __syncthreads();
            { GemmDesc g{(const bf16_t*)(ws + W_QM), (const bf16_t*)(ws + W_MK), nullptr, 1024, 1024, 256, 128, 4, 1}; EpiArgs e{(bf16_t*)(ws + W_P), 1024, 1.f, nullptr, 0};
              gemm_phase<EPI_S>(lds, p, g, e, c, G, wv); }
            __syncthreads();
            { GemmDesc g{(const bf16_t*)(ws + W_P), (const bf16_t*)(ws + W_MVT), nullptr, 1024, 512, 256, 128, 4, 2}; EpiArgs e{(bf16_t*)(ws + W_OM), 1024, 1.f, nullptr, 0};
              gemm_phase<EPI_BF>(lds, p, g, e, c, G, wv); }
            { const int tid = ltid(wv); __syncthreads();
              if (tid == 0) { while (__hip_atomic_load((unsigned*)(ws + W_CTL) + 640, __ATOMIC_RELAXED, __HIP_MEMORY_SCOPE_AGENT) < 256u) __builtin_amdgcn_s_sleep(1);
                  __builtin_amdgcn_fence(__ATOMIC_ACQUIRE, "agent"); asm volatile("s_waitcnt vmcnt(0)" ::: "memory"); }
              __syncthreads(); }
            for (int it = c; it < 256; it += G) sample_attn<256, 256, false, 4>(p, lds, it >> 4, (it >> 2) & 3, (it & 3) * 4, wv);
            } PH_END
    PH_BEGIN(5) {
            small_gemm<8, false>(lds, (const bf16_t*)(ws + W_SOM), 1024, (const bf16_t*)(ws + W_BT_MO), 1024, 1024, 1024, (float*)(ws + W_SY), 1024, nullptr, c, G, wv);
            GemmDesc g{(const bf16_t*)(ws + W_OM), (const bf16_t*)(ws + W_BT_MO), nullptr, 1024, 1024, 1024, 128, 4, 0}; EpiArgs e{nullptr, 1024, 1.f, nullptr, 1};
            gemm_phase<EPI_YN>(lds, p, g, e, c, G, wv); } PH_END
    PH_BEGIN(6) {
            for (int base = c * 8; base < 8 * 88; base += G * 8) sample_e_block(p, 1, base / 88, wv);
            __syncthreads();
            small_gemm<1, true>(lds, HS, 1024, (const bf16_t*)(ws + W_BT_GU), 1024, 1024, 5632, nullptr, 2816, (bf16_t*)(ws + W_SHID), c, G, wv);
            GemmDesc g{H, (const bf16_t*)(ws + W_BT_GU), nullptr, 1024, 1024, 1024, 128, 22, 0}; EpiArgs e{(bf16_t*)(ws + W_HID), 2816, 1.f, nullptr, 0};
            gemm_phase<EPI_GU>(lds, p, g, e, c, G, wv); } PH_END
    PH_BEGIN(7) {
            small_gemm<8, false>(lds, (const bf16_t*)(ws + W_SHID), 2816, (const bf16_t*)(ws + W_BT_DN), 2816, 2816, 1024, (float*)(ws + W_SY), 1024, nullptr, c, G, wv);
            { const int tid = ltid(wv); LAS int* slot = (LAS int*)(lds + L_MISC);
              for (int base = c; base < 256; base += G) {
                  asm volatile("s_waitcnt vmcnt(0)" ::: "memory"); __syncthreads();
                  if (tid == 0) { __builtin_amdgcn_fence(__ATOMIC_RELEASE, "agent"); asm volatile("s_waitcnt vmcnt(0)" ::: "memory");
                      const unsigned old = __hip_atomic_fetch_add((unsigned*)(ws + W_CTL) + 600 + (base & 7), 1u, __ATOMIC_RELAXED, __HIP_MEMORY_SCOPE_AGENT);
                      if (old == 31u) { __builtin_amdgcn_fence(__ATOMIC_ACQUIRE, "agent"); asm volatile("s_waitcnt vmcnt(0)" ::: "memory"); }
                      slot[0] = old == 31u ? 1 : 0; }
                  __syncthreads();
                  const int last = slot[0];
                  __syncthreads();
                  if (last) { const int wid = tid >> 6, lane = tid & 63;
#pragma unroll 1
                      for (int i = 0; i < 4; ++i) e_row<true>(p, (base & 7) * 32 + wid * 4 + i, 2, lane, nullptr); }
              } }
            GemmDesc g{(const bf16_t*)(ws + W_HID), (const bf16_t*)(ws + W_BT_DN), nullptr, 2816, 2816, 2816, 128, 4, 0}; EpiArgs e{nullptr, 1024, 1.f, nullptr, 2};
            gemm_phase<EPI_YN>(lds, p, g, e, c, G, wv); } PH_END
}

constexpr int N_PHASES = 8;

extern "C" void kernel_launch(void* const* d_in, const int* in_sizes, int n_in, void* d_out, int out_size, void* d_ws, size_t ws_size, hipStream_t stream) {
    static int grid = 0;
    if (grid == 0) {
        int dev = 0, cus = 0, per_cu = 0;
        hipGetDevice(&dev); hipDeviceGetAttribute(&cus, hipDeviceAttributeMultiprocessorCount, dev);
        if (hipFuncSetAttribute((const void*)mega_fwd, hipFuncAttributeMaxDynamicSharedMemorySize, LDS_BYTES) != hipSuccess) { fprintf(stderr, "hipFuncSetAttribute failed\n"); grid = -1; return; }
        if (hipOccupancyMaxActiveBlocksPerMultiprocessor(&per_cu, (const void*)mega_fwd, 512, LDS_BYTES) != hipSuccess || per_cu < 1) { fprintf(stderr, "occupancy query: %d\n", per_cu); grid = -1; return; }
        grid = cus;
        if (n_in != 29 || ws_size < W_END) { fprintf(stderr, "bad shapes: n_in %d ws %zu need %zu\n", n_in, ws_size, (size_t)W_END); grid = -1; return; }
    }
    if (grid < 0) return;
    (void)hipMemsetAsync((char*)d_ws + W_CTL, 0, 24576, stream);
    Params p{};
    for (int i = 0; i < 29; ++i) p.in[i] = (const float*)d_in[i];
    p.out = (float*)d_out; p.ws = (unsigned char*)d_ws;
#if N_LAUNCH_PER_PHASE
    for (int ph = 0; ph < N_PHASES; ++ph) { p.ph_lo = ph; p.ph_hi = ph + 1; void* args[] = {&p}; hipLaunchKernel((const void*)mega_fwd, dim3(grid), dim3(512), args, LDS_BYTES, stream); }
#else
    p.ph_lo = 0; p.ph_hi = N_PHASES;
    void* args[] = {&p};
    hipError_t e = hipLaunchCooperativeKernel((const void*)mega_fwd, dim3(grid), dim3(512), args, LDS_BYTES, stream);
    if (e != hipSuccess) fprintf(stderr, "cooperative launch failed: %s (grid %d)\n", hipGetErrorString(e), grid);
#endif
}
```

```cpp
#include <hip/hip_runtime.h>
#include <hip/hip_cooperative_groups.h>
#include <cstdio>
namespace cg = cooperative_groups;

#ifndef DUP_MASK
#define DUP_MASK 0
#endif
#ifndef DUP_BAR
#define DUP_BAR 0
#endif
#ifndef N_LAUNCH_PER_PHASE
#define N_LAUNCH_PER_PHASE 0
#endif

#define DI __device__ __forceinline__
#define LAS __attribute__((address_space(3)))
typedef unsigned short bf16_t;
typedef short bf16x8 __attribute__((ext_vector_type(8)));
typedef float f32x4 __attribute__((ext_vector_type(4)));
typedef float f32x16 __attribute__((ext_vector_type(16)));
typedef float f32x2 __attribute__((ext_vector_type(2)));
typedef unsigned u32x4 __attribute__((ext_vector_type(4)));
typedef unsigned u32x2 __attribute__((ext_vector_type(2)));
typedef __bf16 bf2_t __attribute__((ext_vector_type(2)));

constexpr int DM = 1024, TP = 16384, MP = 32768, MS = 256;
constexpr float LOG2E = 1.4426950408889634f;
constexpr float EPS = 1e-6f;
constexpr size_t O_YP = 0, O_YS = O_YP + (size_t)MP * DM, O_AKP = O_YS + 262144, O_AVP = O_AKP + 524288, O_CVP = O_AVP + 524288,
                 O_MKP = O_CVP + 30720, O_MVP = O_MKP + 524288, O_AKS = O_MVP + 524288, O_AVS = O_AKS + 4194304, O_CVS = O_AVS + 4194304;
constexpr size_t W_CTL = 0, W_XBAR = 8192, W_SS = 24576, W_ZERO_END = W_SS + 3 * 32768 * 4;
constexpr size_t W_BT_IN = W_ZERO_END, W_BT_OUT = W_BT_IN + 2560 * 1024 * 2, W_BT_MQ = W_BT_OUT + 2097152, W_BT_MK = W_BT_MQ + 2097152,
                 W_BT_MV = W_BT_MK + 2097152, W_BT_MO = W_BT_MV + 2097152, W_BT_GU = W_BT_MO + 2097152, W_BT_DN = W_BT_GU + 5632 * 1024 * 2,
                 W_H = W_BT_DN + 1024 * 2816 * 2, W_MEMN = W_H + (size_t)33024 * 1024 * 2, W_MK = W_MEMN + 1048576, W_MVT = W_MK + 1048576,
                 W_Y = W_MVT + 1048576, W_Q = W_Y + 67108864, W_K = W_Q + 33554432, W_VT = W_K + 33554432, W_U = W_VT + 33554432,
                 W_MIX = W_U + 33554432, W_SPROJ = W_MIX + 67108864, W_SMIX = W_SPROJ + 256 * 2560 * 4, W_SY = W_SMIX + 524288,
                 W_SX = W_SY + 1048576, W_SQM = W_SX + 1048576, W_SOM = W_SQM + 1048576, W_SHID = W_SOM + 524288, W_XR = W_SHID + 256 * 2816 * 2, W_XRS2 = W_XR + (size_t)33024 * 1024 * 2, W_XCH = W_XRS2 + 256 * 1024 * 2, W_END = W_XCH + (size_t)3 * 2 * 32768 * 4 * 4;
constexpr size_t W_QM = W_Q, W_P = W_VT, W_OM = W_MIX, W_HID = W_Q;
constexpr int L_STAGE = 0, L_X = 131072, L_BIAS = L_X + 8192, L_MISC = L_BIAS + 8448, LDS_BYTES = L_MISC + 4096;

struct Params { const float* in[29]; float* out; unsigned char* ws; int ph_lo, ph_hi; };

DI unsigned pk_bf16(float lo, float hi) { f32x2 v = {lo, hi}; bf2_t b = __builtin_convertvector(v, bf2_t); return __builtin_bit_cast(unsigned, b); }
DI float bf_lo(unsigned w) { return __uint_as_float(w << 16); }
DI float bf_hi(unsigned w) { return __uint_as_float(w & 0xffff0000u); }
DI float fast_exp2(float x) { return __builtin_amdgcn_exp2f(x); }
DI float sigmoidf_(float x) { return __builtin_amdgcn_rcpf(1.0f + fast_exp2(-x * LOG2E)); }
DI int perm16(int k) { return 8 * ((k >> 2) & 1) + 4 * (k >> 3) + (k & 3); }
DI int crow(int i, int h) { return (i & 3) + 8 * (i >> 2) + 4 * h; }
DI int ltid(int wv) { int l; asm volatile("v_mbcnt_lo_u32_b32 %0, -1, 0\n\tv_mbcnt_hi_u32_b32 %0, -1, %0" : "=v"(l)); return wv * 64 + l; }
DI int lzero() { int z = 0; asm volatile("" : "+s"(z)); return z; }
DI float xh_max(float v) { const unsigned u = __float_as_uint(v); const auto r = __builtin_amdgcn_permlane32_swap(u, u, false, false); return fmaxf(__uint_as_float(r[0]), __uint_as_float(r[1])); }
DI float xh_sum(float v) { const unsigned u = __float_as_uint(v); const auto r = __builtin_amdgcn_permlane32_swap(u, u, false, false); return __uint_as_float(r[0]) + __uint_as_float(r[1]); }
#define MFMA32(a, b, c) __builtin_amdgcn_mfma_f32_32x32x16_bf16((a), (b), (c), 0, 0, 0)

constexpr int BM = 256, BK = 64, HALF = 128, HTB = HALF * BK * 2, NXCD = 8, WGM = 8;
DI int lds_byte(int r, int c) { const int st = (r >> 4) * 2 + (c >> 5), rr = r & 15, cc = c & 31, ob = rr * 64 + cc * 2; return st * 1024 + (ob ^ (((ob >> 9) & 1) << 5)); }
DI void stage_rc(int b, int& R, int& C) { const int st = b / 1024, sb = b % 1024, swz = sb ^ (((sb >> 9) & 1) << 5); R = (st >> 1) * 16 + swz / 64; C = (st & 1) * 32 + (swz % 64) / 2; }
DI int perm32(int rho) { const int n = rho >> 4, i = rho & 15; return 8 * (i >> 2) + 4 * n + (i & 3); }

struct Unit { int pm, pn, kind; };
struct GemmDesc { const bf16_t* A; const bf16_t* Bt; const bf16_t* A2; int lda, ldb, K, nM, nN, mode; };
enum { EPI_G1 = 0, EPI_KV = 1, EPI_Y = 2, EPI_BF = 3, EPI_S = 4, EPI_GU = 5, EPI_YN = 6 };
struct EpiArgs { bf16_t* o; int ldo; float scale; float* ss; int stage; };

DI bool sched_next(const GemmDesc& g, int i, int c, int G, Unit& u) {
    if (g.mode == 3) { if (i > 0 || c >= 16) return false; if (c < 8) { u.pm = c >> 2; u.pn = c & 3; u.kind = 0; } else { u.pm = (c - 8) >> 1; u.pn = (c - 8) & 1; u.kind = 1; } return true; }
    const int nwg = g.nM * g.nN; const long L = (long)i * G + c; if (L >= nwg) return false;
    int wgid = (int)L; { const int q = nwg / NXCD, r = nwg % NXCD, xcd = wgid % NXCD, off = wgid / NXCD; wgid = (xcd < r ? xcd * (q + 1) : r * (q + 1) + (xcd - r) * q) + off; }
    const int nig = WGM * g.nN, gid = wgid / nig, fm = gid * WGM, gsz = (g.nM - fm) < WGM ? (g.nM - fm) : WGM;
    u.pm = fm + ((wgid % nig) % gsz); u.pn = (wgid % nig) / gsz; u.kind = 0; return true;
}
DI void unit_ptrs(const GemmDesc& g, const Unit& u, const char*& cA, const char*& cB) {
    if (g.mode == 0) { cA = (const char*)g.A + (size_t)u.pm * 256 * g.lda * 2; cB = (const char*)g.Bt + (size_t)u.pn * 256 * g.ldb * 2; }
    else if (g.mode == 1) { cA = (const char*)g.A + ((size_t)u.pm * 256 * g.lda + u.pn * 256) * 2; cB = (const char*)g.Bt + ((size_t)(u.pm >> 6) * 256 * g.ldb + u.pn * 256) * 2; }
    else if (g.mode == 2) { cA = (const char*)g.A + ((size_t)u.pm * 256 * g.lda + u.pn * 256) * 2; cB = (const char*)g.Bt + ((size_t)u.pn * 256 * g.ldb + (u.pm >> 6) * 256) * 2; }
    else { if (u.kind == 0) { cA = (const char*)g.A + (size_t)u.pm * 256 * 1024 * 2; cB = (const char*)g.Bt + (size_t)u.pn * 256 * 1024 * 2; }
           else { cA = (const char*)g.A2 + (size_t)u.pm * 256 * 1024 * 2; cB = (const char*)g.A + (size_t)u.pn * 256 * 1024 * 2; } }
}

template <int EPI>
DI void epilogue(const Params& p, const EpiArgs& e, f32x4 (&acc)[2][2][4][2], const Unit& u, int wr, int wc, int fr, int fq, LAS unsigned char* lds) {
    unsigned char* ws = p.ws; asm volatile("" : "+v"(fr), "+v"(fq));
    if constexpr (EPI == EPI_G1) {
        const int b = u.pm >> 6, tb = (u.pm & 63) * 256, pn = u.pn;
        const bool tail = (u.pm & 63) >= 62;
#pragma unroll
        for (int ai = 0; ai < 2; ++ai)
#pragma unroll
            for (int m = 0; m < 4; ++m) {
                const int rl = 128 * ai + 64 * wr + 16 * m + fr; const int t = tb + rl; const size_t grow = (size_t)u.pm * 256 + rl;
                if (pn < 2) {
                    const float sc = 0.125f * LOG2E;
#pragma unroll
                    for (int bj = 0; bj < 2; ++bj) { const int col = 256 * pn + 128 * bj + 32 * wc + 8 * fq; const f32x4 v0 = acc[ai][bj][m][0] * sc, v1 = acc[ai][bj][m][1] * sc;
                        u32x4 w; w.x = pk_bf16(v0[0], v0[1]); w.y = pk_bf16(v0[2], v0[3]); w.z = pk_bf16(v1[0], v1[1]); w.w = pk_bf16(v1[2], v1[3]);
                        *(u32x4*)((bf16_t*)(ws + W_Q) + grow * 512 + col) = w; }
                } else if (pn < 4) {
#pragma unroll
                    for (int bj = 0; bj < 2; ++bj) { const int col = 256 * (pn - 2) + 128 * bj + 32 * wc + 8 * fq; const f32x4 v0 = acc[ai][bj][m][0], v1 = acc[ai][bj][m][1];
                        u32x4 w; w.x = pk_bf16(v0[0], v0[1]); w.y = pk_bf16(v0[2], v0[3]); w.z = pk_bf16(v1[0], v1[1]); w.w = pk_bf16(v1[2], v1[3]);
                        *(u32x4*)((bf16_t*)(ws + W_K) + grow * 512 + col) = w;
                        if (tail) { float* o = p.out + O_AKP + ((size_t)b * 512 + (t - 15872)) * 512 + col; *(f32x4*)o = v0; *(f32x4*)(o + 4) = v1; } }
                } else if (pn < 6) {
#pragma unroll
                    for (int bj = 0; bj < 2; ++bj) { const int col = 256 * (pn - 4) + 128 * bj + 32 * wc + 8 * fq; const f32x4 v0 = acc[ai][bj][m][0], v1 = acc[ai][bj][m][1];
                        bf16_t* vt = (bf16_t*)(ws + W_VT) + ((size_t)b * 512 + col) * TP + (t & ~15) + perm16(t & 15);
#pragma unroll
                        for (int j = 0; j < 4; ++j) { vt[(size_t)j * TP] = (bf16_t)(pk_bf16(v0[j], 0.f) & 0xffffu); vt[(size_t)(4 + j) * TP] = (bf16_t)(pk_bf16(v1[j], 0.f) & 0xffffu); }
                        if (tail) { float* o = p.out + O_AVP + ((size_t)b * 512 + (t - 15872)) * 512 + col; *(f32x4*)o = v0; *(f32x4*)(o + 4) = v1; } }
                } else {
                    const int ch = 128 * (pn - 6) + 32 * wc + 8 * fq; f32x4 u0, u1;
#pragma unroll
                    for (int j = 0; j < 4; ++j) { u0[j] = acc[ai][0][m][0][j] * sigmoidf_(acc[ai][1][m][0][j]); u1[j] = acc[ai][0][m][1][j] * sigmoidf_(acc[ai][1][m][1][j]); }
                    u32x4 w; w.x = pk_bf16(u0[0], u0[1]); w.y = pk_bf16(u0[2], u0[3]); w.z = pk_bf16(u1[0], u1[1]); w.w = pk_bf16(u1[2], u1[3]);
                    *(u32x4*)((bf16_t*)(ws + W_U) + grow * 512 + ch) = w;
                    if (t >= TP - 30) { float* o = p.out + O_CVP + ((size_t)b * 30 + (t - (TP - 30))) * 512 + ch; *(f32x4*)o = u0; *(f32x4*)(o + 4) = u1; }
                }
            }
    } else if constexpr (EPI == EPI_KV) {
#pragma unroll
        for (int ai = 0; ai < 2; ++ai)
#pragma unroll
            for (int m = 0; m < 4; ++m)
#pragma unroll
                for (int bj = 0; bj < 2; ++bj) {
                    const int row = 256 * u.pm + 128 * ai + 64 * wr + 16 * m + fr, col = 256 * u.pn + 128 * bj + 32 * wc + 8 * fq;
                    const f32x4 v0 = acc[ai][bj][m][0], v1 = acc[ai][bj][m][1];
                    u32x4 w; w.x = pk_bf16(v0[0], v0[1]); w.y = pk_bf16(v0[2], v0[3]); w.z = pk_bf16(v1[0], v1[1]); w.w = pk_bf16(v1[2], v1[3]);
                    if (u.kind == 0) { *(u32x4*)((bf16_t*)(ws + W_MK) + (size_t)row * 1024 + col) = w; float* o = p.out + O_MKP + (size_t)row * 1024 + col; *(f32x4*)o = v0; *(f32x4*)(o + 4) = v1; }
                    else { *(u32x4*)((bf16_t*)(ws + W_MVT) + (size_t)row * 512 + col) = w; float* o = p.out + O_MVP + (size_t)col * 1024 + row;
#pragma unroll
                        for (int j = 0; j < 4; ++j) { o[(size_t)j * 1024] = v0[j]; o[(size_t)(4 + j) * 1024] = v1[j]; } }
                }
    } else if constexpr (EPI == EPI_Y) {
#pragma unroll
        for (int ai = 0; ai < 2; ++ai)
#pragma unroll
            for (int m = 0; m < 4; ++m) {
                const size_t row = (size_t)256 * u.pm + 128 * ai + 64 * wr + 16 * m + fr; float ss = 0.f;
#pragma unroll
                for (int bj = 0; bj < 2; ++bj) { const int col = 256 * u.pn + 128 * bj + 32 * wc + 8 * fq; const f32x4 v0 = acc[ai][bj][m][0], v1 = acc[ai][bj][m][1];
                    ss += (v0[0] * v0[0] + v0[1] * v0[1]) + (v0[2] * v0[2] + v0[3] * v0[3]) + (v1[0] * v1[0] + v1[1] * v1[1]) + (v1[2] * v1[2] + v1[3] * v1[3]);
                    u32x4 w; w.x = pk_bf16(v0[0], v0[1]); w.y = pk_bf16(v0[2], v0[3]); w.z = pk_bf16(v1[0], v1[1]); w.w = pk_bf16(v1[2], v1[3]);
                    *(u32x4*)(e.o + row * e.ldo + col) = w; }
                ss += __shfl_xor(ss, 16); ss = xh_sum(ss);
                if (fq == 0) __hip_atomic_fetch_add(e.ss + row, ss, __ATOMIC_RELAXED, __HIP_MEMORY_SCOPE_AGENT);
            }
    } else if constexpr (EPI == EPI_BF) {
#pragma unroll
        for (int ai = 0; ai < 2; ++ai)
#pragma unroll
            for (int m = 0; m < 4; ++m)
#pragma unroll
                for (int bj = 0; bj < 2; ++bj) {
                    const size_t row = (size_t)256 * u.pm + 128 * ai + 64 * wr + 16 * m + fr; const int col = 256 * u.pn + 128 * bj + 32 * wc + 8 * fq;
                    const f32x4 v0 = acc[ai][bj][m][0] * e.scale, v1 = acc[ai][bj][m][1] * e.scale;
                    u32x4 w; w.x = pk_bf16(v0[0], v0[1]); w.y = pk_bf16(v0[2], v0[3]); w.z = pk_bf16(v1[0], v1[1]); w.w = pk_bf16(v1[2], v1[3]);
                    *(u32x4*)(e.o + row * e.ldo + col) = w; }
    } else if constexpr (EPI == EPI_S) {
        LAS f32x2* X = (LAS f32x2*)(lds + L_X);
#pragma unroll
        for (int ai = 0; ai < 2; ++ai)
#pragma unroll
            for (int m = 0; m < 4; ++m) {
                float mx = -3.0e38f;
#pragma unroll
                for (int bj = 0; bj < 2; ++bj)
#pragma unroll
                    for (int n = 0; n < 2; ++n)
#pragma unroll
                        for (int j = 0; j < 4; ++j) mx = fmaxf(mx, acc[ai][bj][m][n][j]);
                mx = fmaxf(mx, __shfl_xor(mx, 16)); mx = xh_max(mx);
                float s = 0.f;
#pragma unroll
                for (int bj = 0; bj < 2; ++bj)
#pragma unroll
                    for (int n = 0; n < 2; ++n)
#pragma unroll
                        for (int j = 0; j < 4; ++j) { const float pv = fast_exp2(acc[ai][bj][m][n][j] - mx); acc[ai][bj][m][n][j] = pv; s += pv; }
                s += __shfl_xor(s, 16); s = xh_sum(s);
                if (fq == 0) X[(128 * ai + 64 * wr + 16 * m + fr) * 4 + wc] = (f32x2){mx, s};
            }
        asm volatile("s_waitcnt lgkmcnt(0)" ::: "memory"); __builtin_amdgcn_s_barrier(); asm volatile("" ::: "memory");
#pragma unroll
        for (int ai = 0; ai < 2; ++ai)
#pragma unroll
            for (int m = 0; m < 4; ++m) {
                const int rl = 128 * ai + 64 * wr + 16 * m + fr;
                const f32x2 x0 = X[rl * 4 + 0], x1 = X[rl * 4 + 1], x2 = X[rl * 4 + 2], x3 = X[rl * 4 + 3];
                const float M = fmaxf(fmaxf(x0.x, x1.x), fmaxf(x2.x, x3.x));
                const float L = x0.y * fast_exp2(x0.x - M) + x1.y * fast_exp2(x1.x - M) + x2.y * fast_exp2(x2.x - M) + x3.y * fast_exp2(x3.x - M);
                const float own = wc == 0 ? x0.x : (wc == 1 ? x1.x : (wc == 2 ? x2.x : x3.x));
                const float f = fast_exp2(own - M) / L; const size_t row = (size_t)256 * u.pm + rl;
#pragma unroll
                for (int bj = 0; bj < 2; ++bj) { const int col = 256 * u.pn + 128 * bj + 32 * wc + 8 * fq; const f32x4 v0 = acc[ai][bj][m][0] * f, v1 = acc[ai][bj][m][1] * f;
                    u32x4 w; w.x = pk_bf16(v0[0], v0[1]); w.y = pk_bf16(v0[2], v0[3]); w.z = pk_bf16(v1[0], v1[1]); w.w = pk_bf16(v1[2], v1[3]);
                    *(u32x4*)(e.o + row * e.ldo + col) = w; }
                asm volatile("" ::: "memory");
            }
    } else if constexpr (EPI == EPI_YN) {
        const int stage = e.stage, pm = u.pm, pn = u.pn;
        LAS float* Xs = (LAS float*)(lds + L_X);
        const float* gpost = p.in[stage == 0 ? 9 : (stage == 1 ? 18 : 25)];
        const float* gpre = p.in[stage == 0 ? 17 : 24];
        bf16_t* XR = (bf16_t*)(ws + W_XR); bf16_t* Hb = (bf16_t*)(ws + W_H);
        const size_t row0 = (size_t)256 * pm + 64 * wr + fr; const int col0 = 256 * pn + 32 * wc + 8 * fq;
        u32x4 xw[4][2];
#pragma unroll
        for (int m = 0; m < 4; ++m)
#pragma unroll
            for (int bj = 0; bj < 2; ++bj) xw[m][bj] = *(const u32x4*)(XR + (row0 + 16 * m) * DM + col0 + 128 * bj);
#pragma unroll
        for (int ex = 0; ex < 2; ++ex) {
            if (ex == 1 && stage == 2) break;
#pragma unroll
            for (int ai = 0; ai < 2; ++ai)
#pragma unroll
                for (int m = 0; m < 4; ++m) { float ss = 0.f;
#pragma unroll
                    for (int bj = 0; bj < 2; ++bj) { const f32x4 v0 = acc[ai][bj][m][0], v1 = acc[ai][bj][m][1];
                        ss += (v0[0] * v0[0] + v0[1] * v0[1]) + (v0[2] * v0[2] + v0[3] * v0[3]) + (v1[0] * v1[0] + v1[1] * v1[1]) + (v1[2] * v1[2] + v1[3] * v1[3]); }
                    ss += __shfl_xor(ss, 16); ss = xh_sum(ss);
                    if (fq == 0) Xs[ex * 1024 + (128 * ai + 64 * wr + 16 * m + fr) * 4 + wc] = ss; }
            asm volatile("s_waitcnt lgkmcnt(0)" ::: "memory"); __builtin_amdgcn_s_barrier(); asm volatile("" ::: "memory");
            float* xch = (float*)(ws + W_XCH) + ((size_t)(stage * 2 + ex) * 32768 + (size_t)pm * 256) * 4;
            unsigned* cnt = (unsigned*)(ws + W_CTL) + 1024 + ((stage * 2 + ex) * 128 + pm) * 2 + wr;
            if (wc == 0) {
                if (fq == 0) {
#pragma unroll
                    for (int ai = 0; ai < 2; ++ai)
#pragma unroll
                        for (int m = 0; m < 4; ++m) { const int rl = 128 * ai + 64 * wr + 16 * m + fr; const f32x4 t = *(const LAS f32x4*)(Xs + ex * 1024 + rl * 4);
                            __hip_atomic_store(xch + rl * 4 + pn, (t[0] + t[1]) + (t[2] + t[3]), __ATOMIC_RELAXED, __HIP_MEMORY_SCOPE_AGENT); }
                }
                asm volatile("s_waitcnt vmcnt(0)" ::: "memory");
                if (fr == 0 && fq == 0) __hip_atomic_fetch_add(cnt, 1u, __ATOMIC_RELAXED, __HIP_MEMORY_SCOPE_AGENT);
                while ((unsigned)__builtin_amdgcn_readfirstlane((int)__hip_atomic_load(cnt, __ATOMIC_RELAXED, __HIP_MEMORY_SCOPE_AGENT)) < 4u) __builtin_amdgcn_s_sleep(1);
            }
            asm volatile("" ::: "memory"); __builtin_amdgcn_s_barrier(); asm volatile("" ::: "memory");
            float rsv[2][4];
#pragma unroll
            for (int ai = 0; ai < 2; ++ai) { unsigned long long tq[4][2];
#pragma unroll
                for (int m = 0; m < 4; ++m) { const unsigned long long* q = (const unsigned long long*)(xch + (128 * ai + 64 * wr + 16 * m + fr) * 4);
                    tq[m][0] = __hip_atomic_load(q, __ATOMIC_RELAXED, __HIP_MEMORY_SCOPE_AGENT); tq[m][1] = __hip_atomic_load(q + 1, __ATOMIC_RELAXED, __HIP_MEMORY_SCOPE_AGENT); }
#pragma unroll
                for (int m = 0; m < 4; ++m) { const float t0 = __uint_as_float((unsigned)tq[m][0]), t1 = __uint_as_float((unsigned)(tq[m][0] >> 32)), t2 = __uint_as_float((unsigned)tq[m][1]), t3 = __uint_as_float((unsigned)(tq[m][1] >> 32));
                    rsv[ai][m] = rsqrtf(((t0 + t1) + (t2 + t3)) * (1.0f / 1024.0f) + EPS); } }
#pragma unroll
            for (int ai = 0; ai < 2; ++ai) {
            if (ex == 0 && ai == 1) { asm volatile("" ::: "memory");
#pragma unroll
                for (int m = 0; m < 4; ++m)
#pragma unroll
                    for (int bj = 0; bj < 2; ++bj) xw[m][bj] = *(const u32x4*)(XR + (row0 + 128 + 16 * m) * DM + col0 + 128 * bj);
            }
#pragma unroll
            for (int bj = 0; bj < 2; ++bj) { const int col = col0 + 128 * bj;
                const float* gp = ex == 0 ? gpost : gpre; const f32x4 g0 = *(const f32x4*)(gp + col), g1 = *(const f32x4*)(gp + col + 4);
                {
#pragma unroll
                    for (int m = 0; m < 4; ++m) { const size_t row = row0 + 128 * ai + 16 * m; const float rs = rsv[ai][m];
                        if (ex == 0) {
                            const u32x4 w = xw[m][bj];
                            const f32x4 x0 = (f32x4){bf_lo(w.x), bf_hi(w.x), bf_lo(w.y), bf_hi(w.y)}, x1 = (f32x4){bf_lo(w.z), bf_hi(w.z), bf_lo(w.w), bf_hi(w.w)};
                            const f32x4 n0 = x0 + acc[ai][bj][m][0] * rs * g0, n1 = x1 + acc[ai][bj][m][1] * rs * g1;
                            acc[ai][bj][m][0] = n0; acc[ai][bj][m][1] = n1;
                            if (stage == 2) { float* o = p.out + O_YP + row * DM + col; *(f32x4*)o = n0; *(f32x4*)(o + 4) = n1; }
                            else { u32x4 wo; wo.x = pk_bf16(n0[0], n0[1]); wo.y = pk_bf16(n0[2], n0[3]); wo.z = pk_bf16(n1[0], n1[1]); wo.w = pk_bf16(n1[2], n1[3]); *(u32x4*)(XR + row * DM + col) = wo; }
                        } else {
                            const f32x4 h0 = acc[ai][bj][m][0] * rs * g0, h1 = acc[ai][bj][m][1] * rs * g1;
                            u32x4 wo; wo.x = pk_bf16(h0[0], h0[1]); wo.y = pk_bf16(h0[2], h0[3]); wo.z = pk_bf16(h1[0], h1[1]); wo.w = pk_bf16(h1[2], h1[3]); *(u32x4*)(Hb + row * DM + col) = wo;
                        }
                    }
                }
            }
            }
        }
    } else {
#pragma unroll
        for (int ai = 0; ai < 2; ++ai)
#pragma unroll
            for (int m = 0; m < 4; ++m) {
                const size_t row = (size_t)256 * u.pm + 128 * ai + 64 * wr + 16 * m + fr; const int ch = 128 * u.pn + 32 * wc + 8 * fq; f32x4 u0, u1;
#pragma unroll
                for (int j = 0; j < 4; ++j) { const float g0 = acc[ai][0][m][0][j], g1 = acc[ai][0][m][1][j]; u0[j] = g0 * sigmoidf_(g0) * acc[ai][1][m][0][j]; u1[j] = g1 * sigmoidf_(g1) * acc[ai][1][m][1][j]; }
                u32x4 w; w.x = pk_bf16(u0[0], u0[1]); w.y = pk_bf16(u0[2], u0[3]); w.z = pk_bf16(u1[0], u1[1]); w.w = pk_bf16(u1[2], u1[3]);
                *(u32x4*)(e.o + row * e.ldo + ch) = w; }
    }
}

template <int EPI>
DI void gemm_phase(LAS unsigned char* lds, const Params& p, const GemmDesc g, const EpiArgs e, const int c, const int G, const int wv) {
    const int tid = ltid(wv), wid = __builtin_amdgcn_readfirstlane(tid >> 6), lane = tid & 63, wr = wid >> 2, wc = wid & 3, fr = lane & 15, fq = lane >> 4;
    const int K = g.K, nt = K / BK;
    unsigned voffA[2], voffB[2];
#pragma unroll
    for (int i = 0; i < 2; ++i) { int R, C; stage_rc(tid * 16 + i * 8192, R, C); const int Rb = (R & ~31) + perm32(R & 31);
        voffA[i] = (unsigned)(R * g.lda + C) * 2u; voffB[i] = (unsigned)(Rb * g.ldb + C) * 2u; }
    const size_t kstep = (size_t)(BK * 2);
    const size_t hstepA = (size_t)HALF * g.lda * 2, hstepB = (size_t)HALF * g.ldb * 2;
    const unsigned ldsw = (unsigned)wid * 1024u;
    const int aoff = lds_byte(wr * 64 + fr, fq * 8), boff = lds_byte(wc * 32 + fr, fq * 8);
#define G_SA(b, h) (((b) * 2 + (h)) * HTB)
#define G_SB(b, h) ((4 + (b) * 2 + (h)) * HTB)
#define G_STAGE(bufoff, gbase, voff) do { _Pragma("unroll") for (int _i = 0; _i < 2; ++_i) \
        __builtin_amdgcn_global_load_lds((const unsigned*)((const char*)(gbase) + (voff)[_i]), (LAS unsigned*)(lds + (bufoff) + ldsw + _i * 8192), 16, 0, 0); } while (0)
#define G_LDA(dst, b, h) do { _Pragma("unroll") for (int m = 0; m < 4; ++m) _Pragma("unroll") for (int k = 0; k < 2; ++k) dst[m][k] = *(const LAS bf16x8*)(lds + G_SA(b, h) + aoff + m * 2048 + k * 1024); } while (0)
#define G_LDB(dst, b, h) do { _Pragma("unroll") for (int n = 0; n < 2; ++n) _Pragma("unroll") for (int k = 0; k < 2; ++k) dst[n][k] = *(const LAS bf16x8*)(lds + G_SB(b, h) + boff + n * 2048 + k * 1024); } while (0)
#define G_MMA(ai, bj, At, Bt) do { __builtin_amdgcn_s_setprio(1); _Pragma("unroll") for (int m = 0; m < 4; ++m) _Pragma("unroll") for (int n = 0; n < 2; ++n) _Pragma("unroll") for (int k = 0; k < 2; ++k) \
        acc[ai][bj][m][n] = __builtin_amdgcn_mfma_f32_16x16x32_bf16(Bt[n][k], At[m][k], acc[ai][bj][m][n], 0, 0, 0); __builtin_amdgcn_s_setprio(0); } while (0)
#define G_WAIT_V(n) asm volatile("s_waitcnt vmcnt(" #n ")" ::: "memory")
#define G_WAIT_L(n) asm volatile("s_waitcnt lgkmcnt(" #n ")" ::: "memory")
#define G_BAR __builtin_amdgcn_s_barrier()
#define G_SCHED __builtin_amdgcn_sched_barrier(0)
    Unit cur, nxt; int ui = 0;
    if (!sched_next(g, 0, c, G, cur)) return;
    f32x4 acc[2][2][4][2];
#pragma unroll
    for (int a = 0; a < 2; ++a)
#pragma unroll
        for (int b = 0; b < 2; ++b)
#pragma unroll
            for (int m = 0; m < 4; ++m)
#pragma unroll
                for (int n = 0; n < 2; ++n) acc[a][b][m][n] = (f32x4){0.f, 0.f, 0.f, 0.f};
    bf16x8 At[4][2], B0[2][2], B1[2][2];
    const char* cA; const char* cB; unit_ptrs(g, cur, cA, cB);
    G_STAGE(G_SB(0, 0), cB, voffB); G_STAGE(G_SA(0, 0), cA, voffA); G_STAGE(G_SB(0, 1), cB + hstepB, voffB); G_STAGE(G_SA(0, 1), cA + hstepA, voffA);
    if (wr == 1) G_BAR;
    G_WAIT_V(4); G_BAR;
    G_STAGE(G_SB(1, 0), cB + kstep, voffB); G_STAGE(G_SA(1, 0), cA + kstep, voffA); G_STAGE(G_SB(1, 1), cB + hstepB + kstep, voffB);
    G_WAIT_V(6); G_BAR;
    for (;;) {
        const bool has_next = sched_next(g, ui + 1, c, G, nxt);
        const char* nA = cA; const char* nB = cB; if (has_next) unit_ptrs(g, nxt, nA, nB);
        for (int t = 0; t < nt; t += 2) {
            const bool last = (t == nt - 2);
            const char* a1 = cA + (size_t)(t + 1) * kstep;
            const char* a2 = last ? nA : cA + (size_t)(t + 2) * kstep; const char* b2 = last ? nB : cB + (size_t)(t + 2) * kstep;
            const char* a3 = a2 + kstep; const char* b3 = b2 + kstep;
            G_LDB(B0, 0, 0); G_SCHED; G_LDA(At, 0, 0); G_STAGE(G_SA(1, 1), a1 + hstepA, voffA);
            G_WAIT_L(8); G_BAR; G_WAIT_L(0); G_MMA(0, 0, At, B0); G_BAR; G_SCHED;
            G_LDB(B1, 0, 1); G_STAGE(G_SB(0, 0), b2, voffB);
            G_BAR; G_WAIT_L(0); G_MMA(0, 1, At, B1); G_BAR;
            G_LDA(At, 0, 1); G_STAGE(G_SA(0, 0), a2, voffA);
            G_BAR; G_WAIT_L(0); G_MMA(1, 0, At, B0); G_BAR; G_SCHED;
            G_STAGE(G_SB(0, 1), b2 + hstepB, voffB);
            G_WAIT_V(6); G_BAR; G_MMA(1, 1, At, B1); G_BAR;
            G_LDB(B0, 1, 0); G_SCHED; G_LDA(At, 1, 0); G_STAGE(G_SA(0, 1), a2 + hstepA, voffA);
            G_WAIT_L(8); G_BAR; G_WAIT_L(0); G_MMA(0, 0, At, B0); G_BAR; G_SCHED;
            G_LDB(B1, 1, 1); G_STAGE(G_SB(1, 0), b3, voffB);
            G_BAR; G_WAIT_L(0); G_MMA(0, 1, At, B1); G_BAR;
            G_LDA(At, 1, 1); G_STAGE(G_SA(1, 0), a3, voffA);
            G_BAR; G_WAIT_L(0); G_MMA(1, 0, At, B0); G_BAR; G_SCHED;
            G_STAGE(G_SB(1, 1), b3 + hstepB, voffB);
            G_WAIT_V(6); G_BAR; G_MMA(1, 1, At, B1); G_BAR;
        }
        epilogue<EPI>(p, e, acc, cur, wr, wc, fr, fq, lds);
        if (!has_next) break;
#pragma unroll
        for (int a = 0; a < 2; ++a)
#pragma unroll
            for (int b = 0; b < 2; ++b)
#pragma unroll
                for (int m = 0; m < 4; ++m)
#pragma unroll
                    for (int n = 0; n < 2; ++n) acc[a][b][m][n] = (f32x4){0.f, 0.f, 0.f, 0.f};
        cur = nxt; cA = nA; cB = nB; ++ui;
    }
    G_WAIT_V(0);
    if (wr == 0) G_BAR;
    G_BAR;
#undef G_SA
#undef G_SB
#undef G_STAGE
#undef G_LDA
#undef G_LDB
#undef G_MMA
#undef G_WAIT_V
#undef G_WAIT_L
#undef G_BAR
#undef G_SCHED
}

template <int KS, bool PAIR>
DI void small_gemm(LAS unsigned char* lds, const bf16_t* A, int lda, const bf16_t* Bt, int ldb, int K, int N, float* C, int ldc, bf16_t* H, int c, int G, int wv) {
    const int tid = ltid(wv), wid = tid >> 6, lane = tid & 63, r = lane & 31, h = lane >> 5;
    constexpr int TPW = 8 / KS;
    const int ntn = PAIR ? (N / 64) : (N / 32); const int ntiles = 8 * ntn;
    LAS float* red = (LAS float*)(lds + L_STAGE);
    for (int base = c * TPW; base < ntiles; base += G * TPW) {
        const int tile = base + wid / KS, kp = wid % KS; const bool act = tile < ntiles;
        f32x16 acc0, acc1;
#pragma unroll
        for (int i = 0; i < 16; ++i) { acc0[i] = 0.f; acc1[i] = 0.f; }
        int m0 = 0, n0 = 0;
        if (act) {
            const int tm = PAIR ? tile / ntn : tile % 8, tn = PAIR ? tile % ntn : tile / 8; m0 = tm * 32;
            if (PAIR) n0 = (tn >> 2) * 256 + (tn & 3) * 32; else n0 = tn * 32;
            const int klen = K / KS, kb = kp * klen;
            const bf16_t* ap = A + (size_t)(m0 + r) * lda + kb + 8 * h;
            const bf16_t* bp = Bt + (size_t)(n0 + r) * ldb + kb + 8 * h;
#pragma unroll 4
            for (int k = 0; k < klen; k += 16) {
                const bf16x8 a = *(const bf16x8*)(ap + k); const bf16x8 b = *(const bf16x8*)(bp + k);
                acc0 = MFMA32(a, b, acc0);
                if (PAIR) { const bf16x8 b2 = *(const bf16x8*)(bp + (size_t)128 * ldb + k); acc1 = MFMA32(a, b2, acc1); }
            }
        }
        if (KS > 1) {
#pragma unroll
            for (int i = 0; i < 16; ++i) { red[(wid * 16 + i) * 64 + lane] = acc0[i]; if (PAIR) red[8192 + (wid * 16 + i) * 64 + lane] = acc1[i]; }
            __syncthreads();
            if (act && kp == 0) {
                const int ch = (n0 >> 8) * 128 + (n0 & 127) + r;
#pragma unroll
                for (int i = 0; i < 16; ++i) { float s = 0.f, s1 = 0.f;
#pragma unroll
                    for (int q = 0; q < KS; ++q) { s += red[((wid + q) * 16 + i) * 64 + lane]; if (PAIR) s1 += red[8192 + ((wid + q) * 16 + i) * 64 + lane]; }
                    if (PAIR) { const float v = s * sigmoidf_(s) * s1; H[(size_t)(m0 + crow(i, h)) * ldc + ch] = (bf16_t)(pk_bf16(v, 0.f) & 0xffffu); }
                    else C[(size_t)(m0 + crow(i, h)) * ldc + n0 + r] = s; }
            }
            __syncthreads();
        } else if (act) {
            if (PAIR) {
                const int ch = (n0 >> 8) * 128 + (n0 & 127) + r;
#pragma unroll
                for (int i = 0; i < 16; ++i) { const float gt = acc0[i]; const float v = gt * sigmoidf_(gt) * acc1[i]; H[(size_t)(m0 + crow(i, h)) * ldc + ch] = (bf16_t)(pk_bf16(v, 0.f) & 0xffffu); }
            } else {
#pragma unroll
                for (int i = 0; i < 16; ++i) C[(size_t)(m0 + crow(i, h)) * ldc + n0 + r] = acc0[i];
            }
        }
    }
}

DI void transpose_tile(LAS float* T, const float* src, int ldsrc, int k0, int ncol0, bf16_t* dst, int lddst, int nrow0, int tid) {
#pragma unroll
    for (int i = 0; i < 2; ++i) { const int k = (tid >> 4) + 32 * i, n4 = tid & 15; const f32x4 v = __builtin_nontemporal_load((const f32x4*)(src + (size_t)(k0 + k) * ldsrc + ncol0 + n4 * 4));
        T[k * 65 + n4 * 4 + 0] = v[0]; T[k * 65 + n4 * 4 + 1] = v[1]; T[k * 65 + n4 * 4 + 2] = v[2]; T[k * 65 + n4 * 4 + 3] = v[3]; }
    __syncthreads();
    { const int n = tid >> 3, k8 = tid & 7; float v[8];
#pragma unroll
      for (int j = 0; j < 8; ++j) v[j] = T[(k8 * 8 + j) * 65 + n];
      u32x4 w; w.x = pk_bf16(v[0], v[1]); w.y = pk_bf16(v[2], v[3]); w.z = pk_bf16(v[4], v[5]); w.w = pk_bf16(v[6], v[7]);
      *(u32x4*)(dst + (size_t)(nrow0 + n) * lddst + k0 + k8 * 8) = w; }
    __syncthreads();
}
DI float wave_sum(float v) { v += __shfl_xor(v, 1); v += __shfl_xor(v, 2); v += __shfl_xor(v, 4); v += __shfl_xor(v, 8); v += __shfl_xor(v, 16); v = xh_sum(v); return v; }
DI float wave_max(float v) { v = fmaxf(v, __shfl_xor(v, 1)); v = fmaxf(v, __shfl_xor(v, 2)); v = fmaxf(v, __shfl_xor(v, 4)); v = fmaxf(v, __shfl_xor(v, 8)); v = fmaxf(v, __shfl_xor(v, 16)); v = xh_max(v); return v; }
template <bool RAW = false>
DI void norm_row(const float* x, const float* g, bf16_t* dst, int lane, bf16_t* raw = nullptr) {
    f32x4 v[4]; v[0] = __builtin_nontemporal_load((const f32x4*)(x + lane * 8)); v[1] = __builtin_nontemporal_load((const f32x4*)(x + lane * 8 + 4)); v[2] = __builtin_nontemporal_load((const f32x4*)(x + 512 + lane * 8)); v[3] = __builtin_nontemporal_load((const f32x4*)(x + 512 + lane * 8 + 4));
    float ss = 0.f;
#pragma unroll
    for (int i = 0; i < 4; ++i) ss += v[i][0] * v[i][0] + v[i][1] * v[i][1] + v[i][2] * v[i][2] + v[i][3] * v[i][3];
    ss = wave_sum(ss); const float rs = rsqrtf(ss * (1.0f / 1024.0f) + EPS);
    if (RAW) {
#pragma unroll
        for (int hh = 0; hh < 2; ++hh) { const f32x4 a = v[2 * hh], b = v[2 * hh + 1];
            u32x4 w; w.x = pk_bf16(a[0], a[1]); w.y = pk_bf16(a[2], a[3]); w.z = pk_bf16(b[0], b[1]); w.w = pk_bf16(b[2], b[3]); *(u32x4*)(raw + hh * 512 + lane * 8) = w; }
    }
#pragma unroll
    for (int hh = 0; hh < 2; ++hh) { const f32x4 g0 = *(const f32x4*)(g + hh * 512 + lane * 8), g1 = *(const f32x4*)(g + hh * 512 + lane * 8 + 4); const f32x4 a = v[2 * hh] * rs * g0, b = v[2 * hh + 1] * rs * g1;
        u32x4 w; w.x = pk_bf16(a[0], a[1]); w.y = pk_bf16(a[2], a[3]); w.z = pk_bf16(b[0], b[1]); w.w = pk_bf16(b[2], b[3]); *(u32x4*)(dst + hh * 512 + lane * 8) = w; }
}

DI void weight_tile(LAS unsigned char* lds, const Params& p, int ti, int wv) {
    const int tid = ltid(wv); unsigned char* ws = p.ws; LAS float* T = (LAS float*)(lds + L_STAGE);
        const float* src; int ldsrc, k0, ncol0, lddst, nrow0; bf16_t* dst;
        if (ti < 640) { const int kt = ti & 15, nb = ti >> 4; src = p.in[10]; ldsrc = 2560; k0 = kt * 64; dst = (bf16_t*)(ws + W_BT_IN); lddst = 1024; nrow0 = nb * 64;
            if (nb < 24) ncol0 = nb * 64; else { const int q = nb - 24, j = q >> 2, s = (q >> 1) & 1, hf = q & 1; ncol0 = 1536 + s * 512 + j * 128 + hf * 64; } }
        else if (ti < 1920) { const int q = ti - 640, wsel = q >> 8, t2 = q & 255, kt = t2 & 15, nb = t2 >> 4; const int idx[5] = {16, 20, 21, 22, 23};
            const size_t offs[5] = {W_BT_OUT, W_BT_MQ, W_BT_MK, W_BT_MV, W_BT_MO};
            src = p.in[wsel == 0 ? 16 : (wsel == 1 ? 20 : (wsel == 2 ? 21 : (wsel == 3 ? 22 : 23)))]; (void)idx;
            dst = (bf16_t*)(ws + (wsel == 0 ? W_BT_OUT : (wsel == 1 ? W_BT_MQ : (wsel == 2 ? W_BT_MK : (wsel == 3 ? W_BT_MV : W_BT_MO))))); (void)offs;
            ldsrc = 1024; k0 = kt * 64; ncol0 = nb * 64; lddst = 1024; nrow0 = nb * 64; }
        else if (ti < 3328) { const int q = ti - 1920, up = q >= 704 ? 1 : 0, t2 = q - up * 704, kt = t2 & 15, nb = t2 >> 4; src = p.in[up ? 27 : 26]; ldsrc = 2816; k0 = kt * 64; ncol0 = nb * 64;
            dst = (bf16_t*)(ws + W_BT_GU); lddst = 1024; nrow0 = (nb >> 1) * 256 + (nb & 1) * 64 + up * 128; }
        else { const int q = ti - 3328, nb = q & 15, kt = q >> 4; src = p.in[28]; ldsrc = 1024; k0 = kt * 64; ncol0 = nb * 64; dst = (bf16_t*)(ws + W_BT_DN); lddst = 2816; nrow0 = nb * 64; }
        transpose_tile(T, src, ldsrc, k0, ncol0, dst, lddst, nrow0, tid);
}

DI void phase_prep(LAS unsigned char* lds, const Params& p, int c, int G, int wv) {
    const int tid = ltid(wv), wid = tid >> 6, lane = tid & 63; unsigned char* ws = p.ws;
    LAS float* T = (LAS float*)(lds + L_STAGE);
    for (int tj = c; tj < 640 + 512; tj += G) { const int ti = tj < 640 ? tj : 640 + 512 + (tj - 640);
        const float* src; int ldsrc, k0, ncol0, lddst, nrow0; bf16_t* dst;
        if (ti < 640) { const int kt = ti & 15, nb = ti >> 4; src = p.in[10]; ldsrc = 2560; k0 = kt * 64; dst = (bf16_t*)(ws + W_BT_IN); lddst = 1024; nrow0 = nb * 64;
            if (nb < 24) ncol0 = nb * 64; else { const int q = nb - 24, j = q >> 2, s = (q >> 1) & 1, hf = q & 1; ncol0 = 1536 + s * 512 + j * 128 + hf * 64; } }
        else if (ti < 1920) { const int q = ti - 640, wsel = q >> 8, t2 = q & 255, kt = t2 & 15, nb = t2 >> 4; const int idx[5] = {16, 20, 21, 22, 23};
            const size_t offs[5] = {W_BT_OUT, W_BT_MQ, W_BT_MK, W_BT_MV, W_BT_MO};
            src = p.in[wsel == 0 ? 16 : (wsel == 1 ? 20 : (wsel == 2 ? 21 : (wsel == 3 ? 22 : 23)))]; (void)idx;
            dst = (bf16_t*)(ws + (wsel == 0 ? W_BT_OUT : (wsel == 1 ? W_BT_MQ : (wsel == 2 ? W_BT_MK : (wsel == 3 ? W_BT_MV : W_BT_MO))))); (void)offs;
            ldsrc = 1024; k0 = kt * 64; ncol0 = nb * 64; lddst = 1024; nrow0 = nb * 64; }
        else if (ti < 3328) { const int q = ti - 1920, up = q >= 704 ? 1 : 0, t2 = q - up * 704, kt = t2 & 15, nb = t2 >> 4; src = p.in[up ? 27 : 26]; ldsrc = 2816; k0 = kt * 64; ncol0 = nb * 64;
            dst = (bf16_t*)(ws + W_BT_GU); lddst = 1024; nrow0 = (nb >> 1) * 256 + (nb & 1) * 64 + up * 128; }
        else { const int q = ti - 3328, nb = q & 15, kt = q >> 4; src = p.in[28]; ldsrc = 1024; k0 = kt * 64; ncol0 = nb * 64; dst = (bf16_t*)(ws + W_BT_DN); lddst = 2816; nrow0 = nb * 64; }
        transpose_tile(T, src, ldsrc, k0, ncol0, dst, lddst, nrow0, tid);
    }
    for (int i = c * 512 + tid; i < 3 * 32768 / 4; i += G * 512) ((f32x4*)(ws + W_SS))[i] = (f32x4){0.f, 0.f, 0.f, 0.f};
    for (int row = c * 8 + wid; row < 33024 + 512; row += G * 8) {
        if (row < MP) norm_row<true>(p.in[0] + (size_t)row * DM, p.in[8], (bf16_t*)(ws + W_H) + (size_t)row * DM, lane, (bf16_t*)(ws + W_XR) + (size_t)row * DM);
        else if (row < 33024) norm_row(p.in[1] + (size_t)(row - MP) * DM, p.in[8], (bf16_t*)(ws + W_H) + (size_t)row * DM, lane);
        else norm_row(p.in[7] + (size_t)(row - 33024) * DM, p.in[19], (bf16_t*)(ws + W_MEMN) + (size_t)(row - 33024) * DM, lane);
    }
    { const size_t n4 = (size_t)16 * 496 * 128;
      for (size_t i = (size_t)c * 512 + tid; i < n4; i += (size_t)G * 512) { const size_t bs = i / (496 * 128), rem = i % (496 * 128);
          const size_t so = (bs * 512 + 16) * 512 + rem * 4, dof = bs * 512 * 512 + rem * 4;
          *(f32x4*)(p.out + O_AKS + dof) = *(const f32x4*)(p.in[2] + so); *(f32x4*)(p.out + O_AVS + dof) = *(const f32x4*)(p.in[3] + so); }
      const size_t m4 = (size_t)16 * 14 * 128;
      for (size_t i = (size_t)c * 512 + tid; i < m4; i += (size_t)G * 512) { const size_t bs = i / (14 * 128), rem = i % (14 * 128);
          *(f32x4*)(p.out + O_CVS + bs * 30 * 512 + rem * 4) = *(const f32x4*)(p.in[4] + (bs * 30 + 16) * 512 + rem * 4); } }
}

DI bf16x8 pack8(const f32x16& x, int s) { u32x4 w; w.x = pk_bf16(x[8 * s], x[8 * s + 1]); w.y = pk_bf16(x[8 * s + 2], x[8 * s + 3]); w.z = pk_bf16(x[8 * s + 4], x[8 * s + 5]); w.w = pk_bf16(x[8 * s + 6], x[8 * s + 7]); return __builtin_bit_cast(bf16x8, w); }

DI void attn_item(const Params& p, LAS unsigned char* lds, int b, int c, int wv) {
    const int tid = ltid(wv), hd = tid >> 6, lane = tid & 63, r = lane & 31, h = lane >> 5; unsigned char* ws = p.ws;
    const bf16_t* Q = (const bf16_t*)(ws + W_Q); const bf16_t* Kp = (const bf16_t*)(ws + W_K); const bf16_t* VT = (const bf16_t*)(ws + W_VT);
    const LAS float* bl = (const LAS float*)(lds + L_BIAS) + hd * 257;
    const size_t qrow0 = (size_t)b * TP + c * 64;
    bf16x8 qf[2][4];
#pragma unroll
    for (int qb = 0; qb < 2; ++qb)
#pragma unroll
        for (int ds = 0; ds < 4; ++ds) qf[qb][ds] = *(const bf16x8*)(Q + (qrow0 + qb * 32 + r) * 512 + hd * 64 + ds * 16 + 8 * h);
    f32x16 O[2][2];
#pragma unroll
    for (int a = 0; a < 2; ++a)
#pragma unroll
        for (int q = 0; q < 2; ++q)
#pragma unroll
            for (int i = 0; i < 16; ++i) O[a][q][i] = 0.f;
    float mrow[2] = {0.f, 0.f}, lrow[2] = {0.f, 0.f};
    const float bconst = bl[256];
    const int kb0 = c >= 8 ? 0 : (8 - c) * 2;
    const bf16_t* kbase = Kp + ((size_t)b * TP + (c - 8) * 64 + r) * 512 + hd * 64 + 8 * h;
    const bf16_t* vbase = VT + ((size_t)(b * 8 + hd) * 64 + r) * TP + (c - 8) * 64 + 8 * h;
    bf16x8 kfn[4], vfn[2][2];
#pragma unroll
    for (int ds = 0; ds < 4; ++ds) kfn[ds] = *(const bf16x8*)(kbase + (size_t)kb0 * 32 * 512 + ds * 16);
#pragma unroll
    for (int db = 0; db < 2; ++db)
#pragma unroll
        for (int s = 0; s < 2; ++s) vfn[db][s] = *(const bf16x8*)(vbase + (size_t)db * 32 * TP + kb0 * 32 + s * 16);
    for (int kbi = kb0; kbi < 18; ++kbi) {
        bf16x8 kf[4], vf[2][2];
#pragma unroll
        for (int ds = 0; ds < 4; ++ds) kf[ds] = kfn[ds];
#pragma unroll
        for (int db = 0; db < 2; ++db)
#pragma unroll
            for (int s = 0; s < 2; ++s) vf[db][s] = vfn[db][s];
        if (kbi + 1 < 18) {
#pragma unroll
            for (int ds = 0; ds < 4; ++ds) kfn[ds] = *(const bf16x8*)(kbase + (size_t)(kbi + 1) * 32 * 512 + ds * 16);
#pragma unroll
            for (int db = 0; db < 2; ++db)
#pragma unroll
                for (int s = 0; s < 2; ++s) vfn[db][s] = *(const bf16x8*)(vbase + (size_t)db * 32 * TP + (kbi + 1) * 32 + s * 16);
        }
        const bool first = kbi == kb0;
#pragma unroll
        for (int qb = 0; qb < 2; ++qb) {
            f32x16 S; const float c0 = (kbi >= 12 ? 0.f : bconst) - mrow[qb];
#pragma unroll
            for (int i = 0; i < 16; ++i) S[i] = c0;
#pragma unroll
            for (int ds = 0; ds < 4; ++ds) S = MFMA32(kf[ds], qf[qb][ds], S);
            if (kbi >= 12) {
#pragma unroll
                for (int i = 0; i < 16; ++i) { int idx = qb * 32 + r + 640 - kbi * 32 - crow(i, h); idx = idx < 0 ? 0 : (idx > 256 ? 256 : idx); S[i] += bl[idx]; }
            }
            float mx = fmaxf(fmaxf(fmaxf(S[0], S[1]), fmaxf(S[2], S[3])), fmaxf(fmaxf(S[4], S[5]), fmaxf(S[6], S[7])));
            mx = fmaxf(mx, fmaxf(fmaxf(fmaxf(S[8], S[9]), fmaxf(S[10], S[11])), fmaxf(fmaxf(S[12], S[13]), fmaxf(S[14], S[15]))));
            mx = xh_max(mx);
            if (first || __builtin_amdgcn_ballot_w64(mx > 8.0f) != 0ull) {
                const float d = (first || mx > 8.0f) ? mx : 0.f; const float alpha = fast_exp2(-d); mrow[qb] += d; lrow[qb] *= alpha;
#pragma unroll
                for (int i = 0; i < 16; ++i) S[i] -= d;
#pragma unroll
                for (int db = 0; db < 2; ++db)
#pragma unroll
                    for (int i = 0; i < 16; ++i) O[db][qb][i] *= alpha;
            }
            float rs = 0.f;
#pragma unroll
            for (int i = 0; i < 16; ++i) { const float pv = fast_exp2(S[i]); S[i] = pv; rs += pv; }
            lrow[qb] += rs;
#pragma unroll
            for (int s = 0; s < 2; ++s) { const bf16x8 pf = pack8(S, s);
#pragma unroll
                for (int db = 0; db < 2; ++db) O[db][qb] = MFMA32(vf[db][s], pf, O[db][qb]); }
        }
    }
    bf16_t* MIX = (bf16_t*)(ws + W_MIX);
#pragma unroll
    for (int qb = 0; qb < 2; ++qb) {
        const float l = xh_sum(lrow[qb]); const float inv = 1.0f / l;
#pragma unroll
        for (int db = 0; db < 2; ++db)
#pragma unroll
            for (int g4 = 0; g4 < 4; ++g4) { u32x2 w; w.x = pk_bf16(O[db][qb][4 * g4] * inv, O[db][qb][4 * g4 + 1] * inv); w.y = pk_bf16(O[db][qb][4 * g4 + 2] * inv, O[db][qb][4 * g4 + 3] * inv);
                *(u32x2*)(MIX + (qrow0 + qb * 32 + r) * 1024 + hd * 64 + db * 32 + 8 * g4 + 4 * h) = w; }
    }
}

DI void wave_reduce32(float (&v)[32], int lane) {
#pragma unroll
    for (int s = 0; s < 5; ++s) { const int half = 16 >> s; const unsigned mk = (lane & half) ? 0xffffffffu : 0u;
#pragma unroll
        for (int k = 0; k < half; ++k) { const unsigned ua = __float_as_uint(v[k]), ub = __float_as_uint(v[k + half]);
            const float keep = __uint_as_float((ub & mk) | (ua & ~mk)); const float send = __uint_as_float((ua & mk) | (ub & ~mk)); v[k] = keep + __shfl_xor(send, half); }
        __builtin_amdgcn_sched_barrier(0); }
    v[0] = xh_sum(v[0]);
}

DI void conv_item(const Params& p, LAS unsigned char* lds, int b, int c, int wv) {
    const int tid = ltid(wv), wid = tid >> 6, lane = tid & 63; unsigned char* ws = p.ws;
    const bf16_t* U = (const bf16_t*)(ws + W_U); const int t0 = c * 64;
    for (int idx = tid; idx < 94 * 64; idx += 512) { const int rr = idx >> 6, seg = idx & 63; const int t = t0 - 30 + rr; u32x4 v = (u32x4){0u, 0u, 0u, 0u};
        if (t >= 0) v = *(const u32x4*)(U + ((size_t)b * TP + t) * 512 + seg * 8); *(LAS u32x4*)(lds + rr * 1024 + seg * 16) = v; }
    __syncthreads();
    const int cp = tid & 255, th = tid >> 8; const int zz = lzero();
    LAS float* part = (LAS float*)(lds + 98304);
    LAS f32x2* stats = (LAS f32x2*)(lds + 98304 + 2048);
    float cw0[31], cw1[31];
#pragma unroll
    for (int w = 0; w < 31; ++w) { const f32x2 t2 = *(const f32x2*)(p.in[12] + zz + w * 512 + 2 * cp); cw0[w] = t2.x; cw1[w] = t2.y; }
    const f32x2 cb = *(const f32x2*)(p.in[13] + zz + 2 * cp);
    const f32x2 lg = *(const f32x2*)(p.in[14] + zz + 2 * cp), lb = *(const f32x2*)(p.in[15] + zz + 2 * cp);
    bf16_t* MIX = (bf16_t*)(ws + W_MIX);
#pragma unroll 1
    for (int ps = 0; ps < 2; ++ps) {
        const int tb = th * 32 + ps * 16;
        float a0[16], a1[16];
#pragma unroll
        for (int t = 0; t < 16; ++t) { a0[t] = cb.x; a1[t] = cb.y; }
#pragma unroll
        for (int rr = 0; rr < 46; ++rr) { if ((rr & 7) == 0) asm volatile("" ::: "memory");
            const unsigned w = *(const LAS unsigned*)(lds + (tb + rr) * 1024 + cp * 4); const float v0 = bf_lo(w), v1 = bf_hi(w);
#pragma unroll
            for (int t = 0; t < 16; ++t) { const int wi = rr - t; if (wi >= 0 && wi <= 30) { a0[t] += v0 * cw0[wi]; a1[t] += v1 * cw1[wi]; } } }
        { float v[32];
#pragma unroll
          for (int t = 0; t < 16; ++t) { v[t] = a0[t] + a1[t]; v[16 + t] = a0[t] * a0[t] + a1[t] * a1[t]; }
          wave_reduce32(v, lane); if (lane < 32) part[wid * 32 + lane] = v[0]; }
        __syncthreads();
        if (tid < 32) { const int hh = tid >> 4, t = tid & 15; float s1 = 0.f, s2 = 0.f;
#pragma unroll
            for (int w = 0; w < 4; ++w) { s1 += part[(hh * 4 + w) * 32 + t]; s2 += part[(hh * 4 + w) * 32 + 16 + t]; }
            const float mean = s1 * (1.0f / 512.0f); const float var = fmaxf(s2 * (1.0f / 512.0f) - mean * mean, 0.f); stats[tid] = (f32x2){mean, rsqrtf(var + EPS)}; }
        __syncthreads();
        bf16_t* mp = MIX + ((size_t)b * TP + t0 + tb) * 1024 + 512 + 2 * cp; asm volatile("" : "+v"(mp));
#pragma unroll
        for (int t = 0; t < 16; ++t) { const f32x2 st = stats[th * 16 + t]; const float y0 = (a0[t] - st.x) * st.y * lg.x + lb.x, y1 = (a1[t] - st.x) * st.y * lg.y + lb.y;
            *(unsigned*)(mp + t * 1024) = pk_bf16(y0 * sigmoidf_(y0), y1 * sigmoidf_(y1)); }
        __syncthreads();
    }
}

template <int DH, int NK, bool BAND, int NQ>
DI void sample_attn(const Params& p, LAS unsigned char* lds, int bs, int hd, int q0, int wv) {
    const int tid = ltid(wv), wid = tid >> 6, lane = tid & 63; unsigned char* ws = p.ws;
    LAS float* qs = (LAS float*)(lds + L_STAGE);
    LAS float* sc = (LAS float*)(lds + L_STAGE + 16 * DH * 4);
    const float* qsrc = BAND ? (const float*)(ws + W_SPROJ) : (const float*)(ws + W_SQM); const int ldq = BAND ? 2560 : 1024;
    const float qscale = (BAND ? 0.125f : 0.0625f) * LOG2E;
    for (int i = tid; i < NQ * DH; i += 512) { const int qi = i / DH, d = i % DH; qs[i] = qsrc[(size_t)(bs * 16 + q0 + qi) * ldq + hd * DH + d] * qscale; }
    __syncthreads();
    constexpr int TPK = BAND ? 1 : 2; constexpr int DPT = DH / TPK;
    for (int j0 = 0; j0 < NK; j0 += 512 / TPK) {
        const int j = j0 + tid / TPK, part = tid % TPK;
        if (j < NK) {
            const float* kp;
            if (BAND) kp = j < 512 ? p.in[2] + (((size_t)bs * 512 + j) * 8 + hd) * 64 : (const float*)(ws + W_SPROJ) + (size_t)(bs * 16 + (j - 512)) * 2560 + 512 + hd * 64;
            else kp = p.in[5] + (((size_t)bs * 256 + j) * 4 + hd) * 256 + part * DPT;
            float a[NQ];
#pragma unroll
            for (int q = 0; q < NQ; ++q) a[q] = 0.f;
            for (int d = 0; d < DPT; d += 4) { const f32x4 kv = *(const f32x4*)(kp + d);
#pragma unroll
                for (int q = 0; q < NQ; ++q) { const f32x4 qv = *(const LAS f32x4*)(qs + q * DH + part * DPT + d); a[q] += kv[0] * qv[0] + kv[1] * qv[1] + kv[2] * qv[2] + kv[3] * qv[3]; } }
            if (TPK == 2) {
#pragma unroll
                for (int q = 0; q < NQ; ++q) a[q] += __shfl_xor(a[q], 1);
            }
            if (BAND) {
#pragma unroll
                for (int q = 0; q < NQ; ++q) { int idx = q0 + q + 640 - j; idx = idx < 0 ? 0 : (idx > 256 ? 256 : idx); a[q] += ((const LAS float*)(lds + L_BIAS))[hd * 257 + idx]; }
            }
            if (part == 0) {
#pragma unroll
                for (int q = 0; q < NQ; q += 4) *(LAS f32x4*)(sc + j * 16 + q) = (f32x4){a[q], a[q + 1], a[q + 2], a[q + 3]};
            }
        }
    }
    __syncthreads();
#pragma unroll
    for (int qq = 0; qq < 2; ++qq) { const int q = wid * 2 + qq; if (q >= NQ) continue; float mx = -3.0e38f;
        for (int j = lane; j < NK; j += 64) mx = fmaxf(mx, sc[j * 16 + q]);
        mx = wave_max(mx); float s = 0.f;
        for (int j = lane; j < NK; j += 64) { const float pv = fast_exp2(sc[j * 16 + q] - mx); sc[j * 16 + q] = pv; s += pv; }
        s = wave_sum(s); const float inv = 1.0f / s;
        for (int j = lane; j < NK; j += 64) sc[j * 16 + q] *= inv; }
    __syncthreads();
    { constexpr int QPT = NQ * DH / 512; const int d = tid % DH, qg = tid / DH; float o[QPT];
#pragma unroll
      for (int q = 0; q < QPT; ++q) o[q] = 0.f;
      const float* vb = BAND ? p.in[3] + (((size_t)bs * 512) * 8 + hd) * 64 + d : p.in[6] + (((size_t)bs * 256) * 4 + hd) * 256 + d;
      constexpr int NKC = BAND ? 512 : 256; constexpr int VST = BAND ? 512 : 1024;
      for (int j0 = 0; j0 < NKC; j0 += 16) { float vv[16];
#pragma unroll
          for (int jj = 0; jj < 16; ++jj) vv[jj] = vb[(size_t)(j0 + jj) * VST];
#pragma unroll
          for (int jj = 0; jj < 16; ++jj)
#pragma unroll
              for (int q = 0; q < QPT; ++q) o[q] += sc[(j0 + jj) * 16 + qg * QPT + q] * vv[jj]; }
      if (BAND) {
#pragma unroll
          for (int jj = 0; jj < 16; ++jj) { const float v = ((const float*)(ws + W_SPROJ))[(size_t)(bs * 16 + jj) * 2560 + 1024 + hd * 64 + d];
#pragma unroll
              for (int q = 0; q < QPT; ++q) o[q] += sc[(512 + jj) * 16 + qg * QPT + q] * v; } }
      bf16_t* dst = BAND ? (bf16_t*)(ws + W_SMIX) : (bf16_t*)(ws + W_SOM);
#pragma unroll
      for (int q = 0; q < QPT; ++q) dst[(size_t)(bs * 16 + q0 + qg * QPT + q) * 1024 + hd * DH + d] = (bf16_t)(pk_bf16(o[q], 0.f) & 0xffffu); }
    __syncthreads();
}

DI void sample_conv(const Params& p, LAS unsigned char* lds, int bs, int wv) {
    const int tid = ltid(wv), wid = tid >> 6, lane = tid & 63, ch = tid; unsigned char* ws = p.ws;
    const int zz = lzero(); const float* proj = (const float*)(ws + W_SPROJ) + zz;
    LAS float* ext = (LAS float*)(lds + L_STAGE);
    for (int i = 0; i < 30; ++i) ext[i * 512 + ch] = p.in[4][((size_t)bs * 30 + i) * 512 + ch];
    const int cv = 1536 + 256 * (ch >> 7) + (ch & 127);
    for (int t = 0; t < 16; ++t) { const float val = proj[(size_t)(bs * 16 + t) * 2560 + cv], gt = proj[(size_t)(bs * 16 + t) * 2560 + cv + 128]; const float uu = val * sigmoidf_(gt); ext[(30 + t) * 512 + ch] = uu;
        p.out[O_CVS + ((size_t)bs * 30 + 14 + t) * 512 + ch] = uu;
        p.out[O_AKS + ((size_t)bs * 512 + 496 + t) * 512 + ch] = proj[(size_t)(bs * 16 + t) * 2560 + 512 + ch];
        p.out[O_AVS + ((size_t)bs * 512 + 496 + t) * 512 + ch] = proj[(size_t)(bs * 16 + t) * 2560 + 1024 + ch]; }
    float cw[31];
#pragma unroll
    for (int w = 0; w < 31; ++w) cw[w] = (p.in[12] + zz)[w * 512 + ch];
    const float cb = (p.in[13] + zz)[ch];
    float cc[16];
#pragma unroll
    for (int t = 0; t < 16; ++t) { float a = cb;
#pragma unroll
        for (int w = 0; w < 31; ++w) a += ext[(t + w) * 512 + ch] * cw[w];
        cc[t] = a; asm volatile("" ::: "memory"); }
    LAS float* part = (LAS float*)(lds + 98304); LAS f32x2* stats = (LAS f32x2*)(lds + 98304 + 2048);
    { float v[32];
#pragma unroll
      for (int t = 0; t < 32; ++t) v[t] = t < 16 ? cc[t & 15] : cc[t & 15] * cc[t & 15];
      wave_reduce32(v, lane); if (lane < 32) part[wid * 32 + lane] = v[0]; }
    __syncthreads();
    if (tid < 16) { float s1 = 0.f, s2 = 0.f;
#pragma unroll
        for (int w = 0; w < 8; ++w) { s1 += part[w * 32 + tid]; s2 += part[w * 32 + 16 + tid]; }
        const float mean = s1 * (1.0f / 512.0f); const float var = fmaxf(s2 * (1.0f / 512.0f) - mean * mean, 0.f); stats[tid] = (f32x2){mean, rsqrtf(var + EPS)}; }
    __syncthreads();
    const float lg = (p.in[14] + zz)[ch], lb = (p.in[15] + zz)[ch];
#pragma unroll
    for (int t = 0; t < 16; ++t) { const f32x2 st = stats[t]; const float y = (cc[t] - st.x) * st.y * lg + lb;
        ((bf16_t*)(ws + W_SMIX))[(size_t)(bs * 16 + t) * 1024 + 512 + ch] = (bf16_t)(pk_bf16(y * sigmoidf_(y), 0.f) & 0xffffu); }
    __syncthreads();
}

template <bool SAMPLE>
DI void e_row(const Params& p, int row, int which, int lane, float* dummy) {
    unsigned char* ws = p.ws;
    const float* gpost = p.in[which == 0 ? 9 : (which == 1 ? 18 : 25)];
    const float* gpre = p.in[which == 0 ? 17 : 24];
    const size_t grow = (size_t)(SAMPLE ? MP + row : row);
    bf16_t* xr = (bf16_t*)(ws + W_XR) + grow * DM;
    bf16_t* xr_rd = xr; bf16_t* xr_wr = xr;
    if (SAMPLE) { bf16_t* xb = (bf16_t*)(ws + W_XRS2) + (size_t)row * DM; if (which == 1) xr_wr = xb; if (which == 2) xr_rd = xb; }
    f32x4 y[4]; float rs;
    if (!SAMPLE) {
        const bf16_t* yp = (const bf16_t*)(ws + W_Y) + (size_t)row * DM;
#pragma unroll
        for (int hh = 0; hh < 2; ++hh) { const u32x4 w = *(const u32x4*)(yp + hh * 512 + lane * 8);
            y[2 * hh] = (f32x4){bf_lo(w.x), bf_hi(w.x), bf_lo(w.y), bf_hi(w.y)}; y[2 * hh + 1] = (f32x4){bf_lo(w.z), bf_hi(w.z), bf_lo(w.w), bf_hi(w.w)}; }
        const float ss = ((const float*)(ws + W_SS))[which * 32768 + row]; rs = rsqrtf(ss * (1.0f / 1024.0f) + EPS);
    } else {
        const float* yp = (const float*)(ws + W_SY) + (size_t)row * DM; float ss = 0.f;
#pragma unroll
        for (int hh = 0; hh < 2; ++hh) { y[2 * hh] = *(const f32x4*)(yp + hh * 512 + lane * 8); y[2 * hh + 1] = *(const f32x4*)(yp + hh * 512 + lane * 8 + 4); }
#pragma unroll
        for (int i = 0; i < 4; ++i) ss += y[i][0] * y[i][0] + y[i][1] * y[i][1] + y[i][2] * y[i][2] + y[i][3] * y[i][3];
        ss = wave_sum(ss); rs = rsqrtf(ss * (1.0f / 1024.0f) + EPS);
    }
    f32x4 xn[4]; float s2 = 0.f;
    if (which == 0) {
        const float* xin = (SAMPLE ? p.in[1] : p.in[0]) + (size_t)row * DM;
#pragma unroll
        for (int i = 0; i < 4; ++i) xn[i] = *(const f32x4*)(xin + (i >> 1) * 512 + lane * 8 + (i & 1) * 4);
    } else {
#pragma unroll
        for (int hh = 0; hh < 2; ++hh) { const u32x4 w = *(const u32x4*)(xr_rd + hh * 512 + lane * 8);
            xn[2 * hh] = (f32x4){bf_lo(w.x), bf_hi(w.x), bf_lo(w.y), bf_hi(w.y)}; xn[2 * hh + 1] = (f32x4){bf_lo(w.z), bf_hi(w.z), bf_lo(w.w), bf_hi(w.w)}; }
    }
#pragma unroll
    for (int i = 0; i < 4; ++i) { const int col = (i >> 1) * 512 + lane * 8 + (i & 1) * 4; const f32x4 gv = *(const f32x4*)(gpost + col);
        xn[i] = xn[i] + y[i] * rs * gv; s2 += xn[i][0] * xn[i][0] + xn[i][1] * xn[i][1] + xn[i][2] * xn[i][2] + xn[i][3] * xn[i][3]; }
    if (which == 2) {
        float* xout = (SAMPLE ? p.out + O_YS : p.out + O_YP) + (size_t)row * DM;
#pragma unroll
        for (int i = 0; i < 4; ++i) *(f32x4*)(xout + (i >> 1) * 512 + lane * 8 + (i & 1) * 4) = xn[i];
    } else {
        bf16_t* xw = dummy ? (bf16_t*)dummy + grow * DM : xr_wr;
#pragma unroll
        for (int hh = 0; hh < 2; ++hh) { const f32x4 a = xn[2 * hh], b = xn[2 * hh + 1];
            u32x4 w; w.x = pk_bf16(a[0], a[1]); w.y = pk_bf16(a[2], a[3]); w.z = pk_bf16(b[0], b[1]); w.w = pk_bf16(b[2], b[3]); *(u32x4*)(xw + hh * 512 + lane * 8) = w; }
        s2 = wave_sum(s2); const float r2 = rsqrtf(s2 * (1.0f / 1024.0f) + EPS);
        bf16_t* hp = (bf16_t*)(ws + W_H) + grow * DM;
#pragma unroll
        for (int hh = 0; hh < 2; ++hh) { const int col = hh * 512 + lane * 8; const f32x4 g0 = *(const f32x4*)(gpre + col), g1 = *(const f32x4*)(gpre + col + 4); const f32x4 a = xn[2 * hh] * r2 * g0, b = xn[2 * hh + 1] * r2 * g1;
            u32x4 w; w.x = pk_bf16(a[0], a[1]); w.y = pk_bf16(a[2], a[3]); w.z = pk_bf16(b[0], b[1]); w.w = pk_bf16(b[2], b[3]); *(u32x4*)(hp + col) = w; }
    }
}
DI void sample_e_block(const Params& p, int which, int tm, int wv) {
    const int tid = ltid(wv), wid = tid >> 6, lane = tid & 63;
#pragma unroll 1
    for (int i = 0; i < 4; ++i) e_row<true>(p, tm * 32 + wid * 4 + i, which, lane, nullptr);
}
DI void phase_e(const Params& p, int which, int c, int G, int wv, float* dummy) {
    const int tid = ltid(wv), wid = tid >> 6, lane = tid & 63;
    for (int row = c * 8 + wid; row < MP + MS; row += G * 8) { if (row < MP) e_row<false>(p, row, which, lane, dummy); else e_row<true>(p, row - MP, which, lane, dummy); }
}

#define XB_TMO      128
#define XB_XCNT(j)  (256  + 64 * (j))
#define XB_XSUB(j)  (1280 + 64 * (j))
#define XB_XGEN(j)  (2304 + 64 * (j))
#define XB_TOP      3328
#define XB_TOPGEN   3392
#define XB_SPIN_CAP (1u << 22)
DI unsigned xb_ld(unsigned* p) { return __hip_atomic_load(p, __ATOMIC_RELAXED, __HIP_MEMORY_SCOPE_AGENT); }
DI unsigned xb_add(unsigned* p, unsigned v) { return __hip_atomic_fetch_add(p, v, __ATOMIC_RELAXED, __HIP_MEMORY_SCOPE_AGENT); }
DI unsigned xb_xcc_id() { return (unsigned)__builtin_amdgcn_s_getreg((3 << 11) | 20) & 0xFu; }
#define XB_SPIN(cond, bar) do { unsigned _sp = 0; while (cond) { __builtin_amdgcn_s_sleep(1); \
    if ((++_sp & 255u) == 0u) { if (xb_ld(&(bar)[XB_TMO])) break; if (_sp > XB_SPIN_CAP) { atomicAdd(&(bar)[XB_TMO], 1u); break; } } } } while (0)
DI void xcd_barrier_complete(unsigned* bar, unsigned x, unsigned& nloc, unsigned& nx) {
    const unsigned Gn = gridDim.x; unsigned sum, cnt, mine, sp = 0u;
    for (;;) { sum = 0u; cnt = 0u; mine = 0u;
#pragma unroll
        for (unsigned j = 0; j < 16; ++j) { const unsigned cc = xb_ld(&bar[XB_XCNT(j)]); sum += cc; cnt += (cc > 0u) ? 1u : 0u; mine = (j == x) ? cc : mine; }
        if (sum == Gn) break;
        __builtin_amdgcn_s_sleep(1);
        if ((++sp & 255u) == 0u) { if (xb_ld(&bar[XB_TMO])) break; if (sp > XB_SPIN_CAP) { atomicAdd(&bar[XB_TMO], 1u); break; } } }
    nloc = mine > 0u ? mine : 1u; nx = cnt > 0u ? cnt : 1u;
}
DI void gbar(unsigned* bar, const unsigned x, volatile LAS unsigned* st, int wv) {
    const int tid = ltid(wv);
    asm volatile("s_waitcnt vmcnt(0)" ::: "memory");
    __syncthreads();
    if (tid == 0) {
        __builtin_amdgcn_s_waitcnt(0);
        unsigned nloc = st[0], nx = st[1];
        if (nloc == 0u) { xcd_barrier_complete(bar, x, nloc, nx); st[0] = nloc; st[1] = nx; }
        const unsigned old = xb_add(&bar[XB_XSUB(x)], 1u);
        const unsigned gen = old / nloc;
        if (old + 1u == (gen + 1u) * nloc) {
            __builtin_amdgcn_fence(__ATOMIC_RELEASE, "agent");
            asm volatile("s_waitcnt vmcnt(0)" ::: "memory");
            const unsigned og = xb_add(&bar[XB_TOP], 1u);
            const unsigned tg = og / nx;
            if (og + 1u == (tg + 1u) * nx) xb_add(&bar[XB_TOPGEN], 1u);
            else XB_SPIN(xb_ld(&bar[XB_TOPGEN]) == tg, bar);
            __builtin_amdgcn_fence(__ATOMIC_ACQUIRE, "agent");
            xb_add(&bar[XB_XGEN(x)], 1u);
            asm volatile("s_waitcnt vmcnt(0)" ::: "memory");
        } else {
            XB_SPIN(xb_ld(&bar[XB_XGEN(x)]) == gen, bar);
            __builtin_amdgcn_fence(__ATOMIC_ACQUIRE, "agent");
            asm volatile("s_waitcnt vmcnt(0)" ::: "memory");
        }
    }
    __syncthreads();
}

__global__ void __launch_bounds__(512, 2) mega_fwd(Params p) {
    extern __shared__ __attribute__((aligned(16))) unsigned char smem[];
    LAS unsigned char* lds = (LAS unsigned char*)smem;
    cg::grid_group grid = cg::this_grid();
    const int wv = __builtin_amdgcn_readfirstlane((int)(threadIdx.x >> 6));
    const int G = gridDim.x, c = blockIdx.x; const int tid = ltid(wv); unsigned char* ws = p.ws;
#if !N_LAUNCH_PER_PHASE
    volatile LAS unsigned* xst = (volatile LAS unsigned*)(lds + L_MISC + 64);
    unsigned* xbar = (unsigned*)(ws + W_XBAR); const unsigned xcc = xb_xcc_id();
    if (tid < 2) xst[tid] = 0u;
    if (tid == 0) (void)xb_add(&xbar[XB_XCNT(xcc)], 1u);
    if (p.ph_hi > 1000) grid.sync();
#endif
    const bf16_t* H = (const bf16_t*)(ws + W_H); const bf16_t* HS = H + (size_t)MP * DM;
    float* SS = (float*)(ws + W_SS);
#define PH_BEGIN(k) if ((k) >= p.ph_lo && (k) < p.ph_hi) { if ((k) > p.ph_lo) gbar(xbar, xcc, xst, wv); _Pragma("unroll 1") for (int rep = 0; rep <= ((DUP_MASK >> (k)) & 1); ++rep) { if (DUP_BAR && rep) gbar(xbar, xcc, xst, wv);
#define PH_END } }
    PH_BEGIN(0) phase_prep(lds, p, c, G, wv); PH_END
#ifdef EXTRA_BAR
    for (int xb = 0; xb < EXTRA_BAR; ++xb) gbar(xbar, xcc, xst, wv);
#endif
    PH_BEGIN(1) {
            small_gemm<2, false>(lds, HS, 1024, (const bf16_t*)(ws + W_BT_IN), 1024, 1024, 2560, (float*)(ws + W_SPROJ), 2560, nullptr, c, G, wv);
            GemmDesc g{H, (const bf16_t*)(ws + W_BT_IN), nullptr, 1024, 1024, 1024, 128, 10, 0}; EpiArgs e{nullptr, 0, 1.f, nullptr, 0};
            gemm_phase<EPI_G1>(lds, p, g, e, c, G, wv); } PH_END
    PH_BEGIN(2) {
            { GemmDesc g{(const bf16_t*)(ws + W_MEMN), (const bf16_t*)(ws + W_BT_MK), (const bf16_t*)(ws + W_BT_MV), 1024, 1024, 1024, 0, 0, 3}; EpiArgs e{nullptr, 0, 1.f, nullptr, 0};
              gemm_phase<EPI_KV>(lds, p, g, e, c, G, wv); }
            for (int i = tid; i < 8 * 257; i += 512) ((LAS float*)(lds + L_BIAS))[i] = p.in[11][i] * LOG2E;
            __syncthreads();
            LAS int* slot = (LAS int*)(lds + L_MISC);
#define DYN_LOOP(ctrword, nitems, body) for (;;) { if (tid == 0) slot[0] = (int)atomicAdd((unsigned*)(ws + W_CTL) + (ctrword) + rep * 64, 1u); __syncthreads(); const int it = slot[0]; __syncthreads(); if (it >= (nitems)) break; body; }
#define DYN_LOOP_AHEAD(ctrword, nitems, body) { unsigned* _ctr = (unsigned*)(ws + W_CTL) + (ctrword) + rep * 64; int _nx = 0; if (tid == 0) _nx = (int)atomicAdd(_ctr, 1u); \
    for (;;) { if (tid == 0) slot[0] = _nx; __syncthreads(); const int it = slot[0]; __syncthreads(); if (it >= (nitems)) break; \
        if (tid == 0) _nx = (int)atomicAdd(_ctr, 1u);     \
        body; } }
            DYN_LOOP(48, 16, sample_conv(p, lds, it, wv))
            DYN_LOOP(32, 128, (sample_attn<64, 528, true, 16>(p, lds, it >> 3, it & 7, 0, wv)))
            for (int xq = 0; xq < 8; ++xq) { const int xc = (c + xq) & 7;
                DYN_LOOP(2 + xc, 64, attn_item(p, lds, (xc * 64 + it) >> 8, (xc * 64 + it) & 255, wv)) }
            DYN_LOOP(16, 512, conv_item(p, lds, it >> 8, it & 255, wv))
            DYN_LOOP_AHEAD(80, 1440, { for (int q8 = 0; q8 < 2; ++q8) { const int tq = it * 2 + q8; weight_tile(lds, p, tq < 512 ? 640 + tq : 1664 + (tq - 512), wv); } })
            } PH_END
    PH_BEGIN(3) {
            small_gemm<8, false>(lds, (const bf16_t*)(ws + W_SMIX), 1024, (const bf16_t*)(ws + W_BT_OUT), 1024, 1024, 1024, (float*)(ws + W_SY), 1024, nullptr, c, G, wv);
            GemmDesc g{(const bf16_t*)(ws + W_MIX), (const bf16_t*)(ws + W_BT_OUT), nullptr, 1024, 1024, 1024, 128, 4, 0}; EpiArgs e{nullptr, 1024, 1.f, nullptr, 0};
            gemm_phase<EPI_YN>(lds, p, g, e, c, G, wv); } PH_END
    PH_BEGIN(4) {
            for (int base = c; base < 256; base += G) sample_e_block(p, 0, base % 8, wv);
            __syncthreads();
            small_gemm<8, false>(lds, HS, 1024, (const bf16_t*)(ws + W_BT_MQ), 1024, 1024, 1024, (float*)(ws + W_SQM), 1024, nullptr, c, G, wv);
            { const int tid = ltid(wv); asm volatile("s_waitcnt vmcnt(0)" ::: "memory"); __syncthreads();
              if (tid == 0) { __builtin_amdgcn_fence(__ATOMIC_RELEASE, "agent"); asm volatile("s_waitcnt vmcnt(0)" ::: "memory"); unsigned nt = 0; for (int base = c; base < 256; base += G) ++nt;
                  __hip_atomic_fetch_add((unsigned*)(ws + W_CTL) + 640, nt, __ATOMIC_RELAXED, __HIP_MEMORY_SCOPE_AGENT); } }
            { GemmDesc g{H, (const bf16_t*)(ws + W_BT_MQ), nullptr, 1024, 1024, 1024, 128, 4, 0}; EpiArgs e{(bf16_t*)(ws + W_QM), 1024, 0.0625f * LOG2E, nullptr, 0};
              gemm_phase<EPI_BF>(lds, p, g, e, c, G, wv); }
            __syncthreads();
            { GemmDesc g{(const bf16_t*)(ws + W_QM), (const bf16_t*)(ws + W_MK), nullptr, 1024, 1024, 256, 128, 4, 1}; EpiArgs e{(bf16_t*)(ws + W_P), 1024, 1.f, nullptr, 0};
              gemm_phase<EPI_S>(lds, p, g, e, c, G, wv); }
            __syncthreads();
            { GemmDesc g{(const bf16_t*)(ws + W_P), (const bf16_t*)(ws + W_MVT), nullptr, 1024, 512, 256, 128, 4, 2}; EpiArgs e{(bf16_t*)(ws + W_OM), 1024, 1.f, nullptr, 0};
              gemm_phase<EPI_BF>(lds, p, g, e, c, G, wv); }
            { const int tid = ltid(wv); __syncthreads();
              if (tid == 0) { while (__hip_atomic_load((unsigned*)(ws + W_CTL) + 640, __ATOMIC_RELAXED, __HIP_MEMORY_SCOPE_AGENT) < 256u) __builtin_amdgcn_s_sleep(1);
                  __builtin_amdgcn_fence(__ATOMIC_ACQUIRE, "agent"); asm volatile("s_waitcnt vmcnt(0)" ::: "memory"); }
              __syncthreads(); }
            for (int it = c; it < 256; it += G) sample_attn<256, 256, false, 4>(p, lds, it >> 4, (it >> 2) & 3, (it & 3) * 4, wv);
            } PH_END
    PH_BEGIN(5) {
            small_gemm<8, false>(lds, (const bf16_t*)(ws + W_SOM), 1024, (const bf16_t*)(ws + W_BT_MO), 1024, 1024, 1024, (float*)(ws + W_SY), 1024, nullptr, c, G, wv);
            GemmDesc g{(const bf16_t*)(ws + W_OM), (const bf16_t*)(ws + W_BT_MO), nullptr, 1024, 1024, 1024, 128, 4, 0}; EpiArgs e{nullptr, 1024, 1.f, nullptr, 1};
            gemm_phase<EPI_YN>(lds, p, g, e, c, G, wv); } PH_END
    PH_BEGIN(6) {
            for (int base = c * 4; base < 8 * 88; base += G * 4) sample_e_block(p, 1, base / 88, wv);
            __syncthreads();
            small_gemm<2, true>(lds, HS, 1024, (const bf16_t*)(ws + W_BT_GU), 1024, 1024, 5632, nullptr, 2816, (bf16_t*)(ws + W_SHID), c, G, wv);
            GemmDesc g{H, (const bf16_t*)(ws + W_BT_GU), nullptr, 1024, 1024, 1024, 128, 22, 0}; EpiArgs e{(bf16_t*)(ws + W_HID), 2816, 1.f, nullptr, 0};
            gemm_phase<EPI_GU>(lds, p, g, e, c, G, wv); } PH_END
    PH_BEGIN(7) {
            small_gemm<8, false>(lds, (const bf16_t*)(ws + W_SHID), 2816, (const bf16_t*)(ws + W_BT_DN), 2816, 2816, 1024, (float*)(ws + W_SY), 1024, nullptr, c, G, wv);
            { const int tid = ltid(wv); LAS int* slot = (LAS int*)(lds + L_MISC);
              for (int base = c; base < 256; base += G) {
                  asm volatile("s_waitcnt vmcnt(0)" ::: "memory"); __syncthreads();
                  if (tid == 0) { __builtin_amdgcn_fence(__ATOMIC_RELEASE, "agent"); asm volatile("s_waitcnt vmcnt(0)" ::: "memory");
                      const unsigned old = __hip_atomic_fetch_add((unsigned*)(ws + W_CTL) + 600 + (base & 7), 1u, __ATOMIC_RELAXED, __HIP_MEMORY_SCOPE_AGENT);
                      if (old == 31u) { __builtin_amdgcn_fence(__ATOMIC_ACQUIRE, "agent"); asm volatile("s_waitcnt vmcnt(0)" ::: "memory"); }
                      slot[0] = old == 31u ? 1 : 0; }
                  __syncthreads();
                  const int last = slot[0];
                  __syncthreads();
                  if (last) { const int wid = tid >> 6, lane = tid & 63;
#pragma unroll 1
                      for (int i = 0; i < 4; ++i) e_row<true>(p, (base & 7) * 32 + wid * 4 + i, 2, lane, nullptr); }
              } }
            GemmDesc g{(const bf16_t*)(ws + W_HID), (const bf16_t*)(ws + W_BT_DN), nullptr, 2816, 2816, 2816, 128, 4, 0}; EpiArgs e{nullptr, 1024, 1.f, nullptr, 2};
            gemm_phase<EPI_YN>(lds, p, g, e, c, G, wv); } PH_END
}

constexpr int N_PHASES = 8;

extern "C" void kernel_launch(void* const* d_in, const int* in_sizes, int n_in, void* d_out, int out_size, void* d_ws, size_t ws_size, hipStream_t stream) {
    static int grid = 0;
    if (grid == 0) {
        int dev = 0, cus = 0, per_cu = 0;
        hipGetDevice(&dev); hipDeviceGetAttribute(&cus, hipDeviceAttributeMultiprocessorCount, dev);
        if (hipFuncSetAttribute((const void*)mega_fwd, hipFuncAttributeMaxDynamicSharedMemorySize, LDS_BYTES) != hipSuccess) { fprintf(stderr, "hipFuncSetAttribute failed\n"); grid = -1; return; }
        if (hipOccupancyMaxActiveBlocksPerMultiprocessor(&per_cu, (const void*)mega_fwd, 512, LDS_BYTES) != hipSuccess || per_cu < 1) { fprintf(stderr, "occupancy query: %d\n", per_cu); grid = -1; return; }
        grid = cus;
        if (n_in != 29 || ws_size < W_END) { fprintf(stderr, "bad shapes: n_in %d ws %zu need %zu\n", n_in, ws_size, (size_t)W_END); grid = -1; return; }
    }
    if (grid < 0) return;
    (void)hipMemsetAsync((char*)d_ws + W_CTL, 0, 24576, stream);
    Params p{};
    for (int i = 0; i < 29; ++i) p.in[i] = (const float*)d_in[i];
    p.out = (float*)d_out; p.ws = (unsigned char*)d_ws;
#if N_LAUNCH_PER_PHASE
    for (int ph = 0; ph < N_PHASES; ++ph) { p.ph_lo = ph; p.ph_hi = ph + 1; void* args[] = {&p}; hipLaunchKernel((const void*)mega_fwd, dim3(grid), dim3(512), args, LDS_BYTES, stream); }
#else
    p.ph_lo = 0; p.ph_hi = N_PHASES;
    void* args[] = {&p};
    hipError_t e = hipLaunchCooperativeKernel((const void*)mega_fwd, dim3(grid), dim3(512), args, LDS_BYTES, stream);
    if (e != hipSuccess) fprintf(stderr, "cooperative launch failed: %s (grid %d)\n", hipGetErrorString(e), grid);
#endif
}
```
